# Optimizing an MI355X kernel written in HIP

```python
import jax, jax.numpy as jnp
from jax import lax
import numpy as np

D_MODEL = 1024
BATCH = 8
SEQ = 4096
DEPTH = 2

GRID_W = 64
CTX_LEN = 256
D_FF = 2816
FFN_RES = 0.5
N_MOD = 9
EPS = 1e-6
CONV_CH = 512
CONV_GROUPS = 8
CONV_WIDTH = 31
NA_HEADS = 8
NA_HEAD_DIM = 64
NA_WIDTH = NA_HEADS * NA_HEAD_DIM
NA_WIN_R = 8
NA_WIN_C = 16
EVEN_IN = 2 * CONV_CH + 3 * NA_WIDTH
MIX_WIDTH = CONV_CH + NA_WIDTH
SC_WIDTH = D_MODEL
SC_CONV = 3
N_EVEN = (DEPTH + 1) // 2
N_ODD = DEPTH // 2

kernel_name = "hybrid_conformer_natten_shortconv_dit"


def rms_norm(x, g):
    xf = x.astype(jnp.float32)
    y = xf * lax.rsqrt(jnp.mean(xf * xf, axis=-1, keepdims=True) + EPS)
    return (y * g.astype(jnp.float32)).astype(x.dtype)


def ada_mod(cond, w, b):
    m = jax.nn.silu(cond) @ w + b
    return m.reshape(cond.shape[0], N_MOD, D_MODEL)


def pre(x, m, k, g):
    return rms_norm(x, g) * (1 + m[:, 3 * k + 1, None]) + m[:, 3 * k, None]


def post(y, m, k, g):
    return m[:, 3 * k + 2, None] * rms_norm(y, g)


def swiglu(h, w_gu, w_down):
    gt, up = jnp.split(h @ w_gu, 2, axis=-1)
    return (jax.nn.silu(gt) * up) @ w_down


def dw_conv(x, w):
    k = w.shape[0]
    return lax.conv_general_dilated(
        x, w[:, None, :].astype(x.dtype), window_strides=(1,),
        padding=[(k // 2, k // 2)], dimension_numbers=("NWC", "WIO", "NWC"),
        feature_group_count=x.shape[-1])


def conformer_conv(u, dw_w, dw_b, ln_g, ln_b):
    a, gt = jnp.split(u, 2, axis=-1)
    v = dw_conv(a * jax.nn.sigmoid(gt), dw_w) + dw_b
    vg = v.reshape(v.shape[:-1] + (CONV_GROUPS, CONV_CH // CONV_GROUPS)).astype(jnp.float32)
    mu = jnp.mean(vg, axis=-1, keepdims=True)
    var = jnp.mean(jnp.square(vg - mu), axis=-1, keepdims=True)
    vn = ((vg - mu) * lax.rsqrt(var + EPS)).reshape(v.shape)
    vn = vn * ln_g.astype(jnp.float32) + ln_b.astype(jnp.float32)
    return jax.nn.silu(vn).astype(u.dtype)


def ctx_attention(q, k, v):
    s = jnp.einsum('bqhd,bkhd->bhqk', q, k).astype(jnp.float32) * (NA_HEAD_DIM ** -0.5)
    p = jax.nn.softmax(s, axis=-1).astype(v.dtype)
    return jnp.einsum('bhqk,bkhd->bqhd', p, v)


def neighbourhood_attention(q, k, v, k_ctx, v_ctx, rpb):
    bsz, s, h, dh = q.shape
    rows = s // GRID_W
    kr = min(NA_WIN_R, rows)
    kc = NA_WIN_C
    qg = q.reshape(bsz, rows, GRID_W, h, dh)
    kg = k.reshape(bsz, rows, GRID_W, h, dh)
    vg = v.reshape(bsz, rows, GRID_W, h, dh)
    row_start = jnp.clip(jnp.arange(rows) - kr // 2, 0, rows - kr)
    cols = jnp.arange(GRID_W)
    col_start = jnp.clip(cols - kc // 2, 0, GRID_W - kc)
    col_idx = col_start[:, None] + jnp.arange(kc)[None, :]
    col_bias_idx = col_idx - cols[:, None] + (NA_WIN_C - 1)
    scale = NA_HEAD_DIM ** -0.5

    def one_row(r):
        q_r = lax.dynamic_index_in_dim(qg, r, axis=1, keepdims=False)
        rs = row_start[r]
        k_rows = lax.dynamic_slice_in_dim(kg, rs, kr, axis=1)
        v_rows = lax.dynamic_slice_in_dim(vg, rs, kr, axis=1)
        k_win = k_rows[:, :, col_idx]
        v_win = v_rows[:, :, col_idx]
        row_bias_idx = rs + jnp.arange(kr) - r + (NA_WIN_R - 1)
        bias = rpb[:, row_bias_idx][:, :, col_bias_idx]
        bias = jnp.transpose(bias, (0, 2, 1, 3)).astype(jnp.float32)
        s_win = jnp.einsum('bwhd,brwjhd->bhwrj', q_r, k_win).astype(jnp.float32) * scale + bias
        s_ctx = jnp.einsum('bwhd,bchd->bhwc', q_r, k_ctx).astype(jnp.float32) * scale
        logits = jnp.concatenate([s_win.reshape(bsz, h, GRID_W, kr * kc), s_ctx], axis=-1)
        p = jax.nn.softmax(logits, axis=-1).astype(v.dtype)
        p_win = p[..., :kr * kc].reshape(bsz, h, GRID_W, kr, kc)
        p_ctx = p[..., kr * kc:]
        return (jnp.einsum('bhwrj,brwjhd->bwhd', p_win, v_win)
                + jnp.einsum('bhwc,bchd->bwhd', p_ctx, v_ctx))

    out = lax.map(one_row, jnp.arange(rows))
    return jnp.moveaxis(out, 0, 1).reshape(bsz, s, h * dh)


def even_mixer(h_lat, h_ctx, w_in, w_out, dw_w, dw_b, ln_g, ln_b, rpb, ctx_out):
    bsz, s, _ = h_lat.shape
    lc = h_ctx.shape[1]
    u = h_lat @ w_in
    y_a = conformer_conv(u[..., :2 * CONV_CH], dw_w, dw_b, ln_g, ln_b)
    q, k, v = jnp.split(u[..., 2 * CONV_CH:], 3, axis=-1)
    q = q.reshape(bsz, s, NA_HEADS, NA_HEAD_DIM)
    k = k.reshape(bsz, s, NA_HEADS, NA_HEAD_DIM)
    v = v.reshape(bsz, s, NA_HEADS, NA_HEAD_DIM)
    y_ctx = None
    if ctx_out:
        u_c = h_ctx @ w_in
        y_a_c = conformer_conv(u_c[..., :2 * CONV_CH], dw_w, dw_b, ln_g, ln_b)
        q_c, k_c, v_c = jnp.split(u_c[..., 2 * CONV_CH:], 3, axis=-1)
        q_c = q_c.reshape(bsz, lc, NA_HEADS, NA_HEAD_DIM)
        k_c = k_c.reshape(bsz, lc, NA_HEADS, NA_HEAD_DIM)
        v_c = v_c.reshape(bsz, lc, NA_HEADS, NA_HEAD_DIM)
        y_b_c = ctx_attention(q_c, k_c, v_c).reshape(bsz, lc, NA_WIDTH)
        y_ctx = jnp.concatenate([y_a_c, y_b_c], axis=-1) @ w_out
    else:
        k_c, v_c = jnp.split(h_ctx @ w_in[:, 2 * CONV_CH + NA_WIDTH:], 2, axis=-1)
        k_c = k_c.reshape(bsz, lc, NA_HEADS, NA_HEAD_DIM)
        v_c = v_c.reshape(bsz, lc, NA_HEADS, NA_HEAD_DIM)
    y_b = neighbourhood_attention(q, k, v, k_c, v_c, rpb)
    y_lat = jnp.concatenate([y_a, y_b], axis=-1) @ w_out
    return y_lat, y_ctx


def short_conv_mixer(h, w_in, w_conv, w_out):
    b_gate, c_gate, xv = jnp.split(h @ w_in, 3, axis=-1)
    return (b_gate * dw_conv(c_gate * xv, w_conv)) @ w_out


def setup_inputs(seed: int = 0) -> dict:
    key = jax.random.key(seed)
    ks = jax.random.split(key, 24)
    nrm = lambda k, shp, s: jax.random.normal(k, shp, jnp.float32) * s
    return {
        "x": nrm(ks[0], (BATCH, SEQ, D_MODEL), 1.0),
        "c": nrm(ks[1], (BATCH, D_MODEL), 1.0),
        "ctx": nrm(ks[2], (BATCH, CTX_LEN, D_MODEL), 1.0),
        "c_ctx": nrm(ks[3], (D_MODEL,), 1.0),
        "w_mod": nrm(ks[4], (DEPTH, D_MODEL, N_MOD * D_MODEL), 0.5 * D_MODEL ** -0.5),
        "b_mod": nrm(ks[5], (DEPTH, N_MOD * D_MODEL), 0.01),
        "norm_g": 1.0 + nrm(ks[6], (DEPTH, 6, D_MODEL), 0.05),
        "ff1_w_gu": nrm(ks[7], (DEPTH, D_MODEL, 2 * D_FF), D_MODEL ** -0.5),
        "ff1_w_down": nrm(ks[8], (DEPTH, D_FF, D_MODEL), D_FF ** -0.5),
        "ff2_w_gu": nrm(ks[9], (DEPTH, D_MODEL, 2 * D_FF), D_MODEL ** -0.5),
        "ff2_w_down": nrm(ks[10], (DEPTH, D_FF, D_MODEL), D_FF ** -0.5),
        "ev_w_in": nrm(ks[11], (N_EVEN, D_MODEL, EVEN_IN), D_MODEL ** -0.5),
        "ev_w_out": nrm(ks[12], (N_EVEN, MIX_WIDTH, D_MODEL), MIX_WIDTH ** -0.5),
        "ev_dw_w": nrm(ks[13], (N_EVEN, CONV_WIDTH, CONV_CH), CONV_WIDTH ** -0.5),
        "ev_dw_b": nrm(ks[14], (N_EVEN, CONV_CH), 0.01),
        "ev_ln_g": 1.0 + nrm(ks[15], (N_EVEN, CONV_CH), 0.05),
        "ev_ln_b": nrm(ks[16], (N_EVEN, CONV_CH), 0.01),
        "ev_rpb": nrm(ks[17], (N_EVEN, NA_HEADS, 2 * NA_WIN_R - 1, 2 * NA_WIN_C - 1), 0.1),
        "od_w_in": nrm(ks[18], (N_ODD, D_MODEL, 3 * SC_WIDTH), D_MODEL ** -0.5),
        "od_conv_w": nrm(ks[19], (N_ODD, SC_CONV, SC_WIDTH), SC_CONV ** -0.5),
        "od_w_out": nrm(ks[20], (N_ODD, SC_WIDTH, D_MODEL), SC_WIDTH ** -0.5),
    }


def reference(x, c, ctx, c_ctx, w_mod, b_mod, norm_g, ff1_w_gu, ff1_w_down, ff2_w_gu, ff2_w_down,
              ev_w_in, ev_w_out, ev_dw_w, ev_dw_b, ev_ln_g, ev_ln_b, ev_rpb,
              od_w_in, od_conv_w, od_w_out):
    x_lat, x_ctx = x, ctx
    for i in range(DEPTH):
        ctx_in = any(j % 2 == 0 for j in range(i, DEPTH))
        ctx_out = any(j % 2 == 0 for j in range(i + 1, DEPTH))
        g = norm_g[i]
        m_lat = ada_mod(c, w_mod[i], b_mod[i])
        m_ctx = ada_mod(c_ctx[None], w_mod[i], b_mod[i])

        x_lat = x_lat + FFN_RES * post(swiglu(pre(x_lat, m_lat, 0, g[0]), ff1_w_gu[i], ff1_w_down[i]), m_lat, 0, g[1])
        if ctx_in:
            x_ctx = x_ctx + FFN_RES * post(swiglu(pre(x_ctx, m_ctx, 0, g[0]), ff1_w_gu[i], ff1_w_down[i]), m_ctx, 0, g[1])

        if i % 2 == 0:
            e = i // 2
            h_l = pre(x_lat, m_lat, 1, g[2])
            h_c = pre(x_ctx, m_ctx, 1, g[2])
            y_l, y_c = even_mixer(h_l, h_c, ev_w_in[e], ev_w_out[e], ev_dw_w[e], ev_dw_b[e],
                                  ev_ln_g[e], ev_ln_b[e], ev_rpb[e], ctx_out)
            x_lat = x_lat + post(y_l, m_lat, 1, g[3])
            if ctx_out:
                x_ctx = x_ctx + post(y_c, m_ctx, 1, g[3])
        else:
            o = i // 2
            x_lat = x_lat + post(short_conv_mixer(pre(x_lat, m_lat, 1, g[2]), od_w_in[o], od_conv_w[o], od_w_out[o]), m_lat, 1, g[3])
            if ctx_out:
                x_ctx = x_ctx + post(short_conv_mixer(pre(x_ctx, m_ctx, 1, g[2]), od_w_in[o], od_conv_w[o], od_w_out[o]), m_ctx, 1, g[3])

        x_lat = x_lat + FFN_RES * post(swiglu(pre(x_lat, m_lat, 2, g[4]), ff2_w_gu[i], ff2_w_down[i]), m_lat, 2, g[5])
        if ctx_out:
            x_ctx = x_ctx + FFN_RES * post(swiglu(pre(x_ctx, m_ctx, 2, g[4]), ff2_w_gu[i], ff2_w_down[i]), m_ctx, 2, g[5])
    return x_lat
```

```cpp
#include <hip/hip_runtime.h>
#include <hip/hip_cooperative_groups.h>
#include <cstdio>
namespace cg = cooperative_groups;

#ifndef ONE_LAUNCH
#define ONE_LAUNCH 1
#endif

#ifndef DUP_PHASE
#define DUP_PHASE -1
#endif
#define LAS __attribute__((address_space(3)))
#define GAS __attribute__((address_space(1)))
typedef unsigned short bf16_t;
typedef short bf16x8 __attribute__((ext_vector_type(8)));
typedef short s16x4 __attribute__((ext_vector_type(4)));
typedef float f32x4 __attribute__((ext_vector_type(4)));
typedef float f32x2 __attribute__((ext_vector_type(2)));
typedef unsigned u32x4 __attribute__((ext_vector_type(4)));
typedef unsigned u32x2 __attribute__((ext_vector_type(2)));

constexpr int D = 1024, NB = 8, SEQ = 4096, ML = NB * SEQ, CTXL = 256, MC = NB * CTXL, MT = ML + MC, DFF = 2816;
constexpr int NMODW = 9 * D;
constexpr float EPS = 1e-6f;
constexpr int NTHREADS = 512;
constexpr int NPH = 22;

constexpr size_t SZ_WGU = (size_t)2 * DFF * D * 2, SZ_WDN = (size_t)D * DFF * 2;
constexpr size_t WS_WGU = 0;
constexpr size_t WS_WDN = WS_WGU + 4 * SZ_WGU;
constexpr size_t WS_WEVIN = WS_WDN + 4 * SZ_WDN;
constexpr size_t WS_WEVOUT = WS_WEVIN + (size_t)2560 * D * 2;
constexpr size_t WS_WODIN = WS_WEVOUT + (size_t)D * D * 2;
constexpr size_t WS_WODOUT = WS_WODIN + (size_t)3072 * D * 2;
constexpr size_t WS_MOD = WS_WODOUT + (size_t)D * D * 2;
constexpr size_t WS_PART = WS_MOD + (size_t)2 * 9 * NMODW * 4;
constexpr size_t WS_H = WS_PART + (size_t)MT * 16 * 4;
constexpr size_t WS_ACT = WS_H + (size_t)MT * D * 2;
constexpr size_t WS_Y = WS_ACT + (size_t)MT * DFF * 2;
constexpr size_t WS_XB = WS_Y + (size_t)MT * D * 2;
constexpr size_t WS_YAB = WS_XB;
constexpr size_t WS_CTL = WS_YAB + (size_t)ML * D * 2;
constexpr size_t CTL_BYTES = 16384;
constexpr size_t WS_END = WS_CTL + CTL_BYTES;
constexpr int LDU = 1024;
constexpr size_t WS_UA = WS_ACT;
constexpr size_t WS_KT = WS_UA + (size_t)ML * LDU * 2;
constexpr size_t WS_KC = WS_KT + (size_t)ML * 512 * 2;
constexpr size_t WS_VT = WS_KC + (size_t)MC * 512 * 2;
constexpr size_t WS_VC = WS_VT + (size_t)ML * 512 * 2;
constexpr size_t WS_CX = WS_ACT;
constexpr size_t WS_BG = WS_CX + (size_t)ML * D * 2;
static_assert(WS_VC + (size_t)MC * 512 * 2 <= WS_Y, "alias overflow");
static_assert(WS_BG + (size_t)ML * D * 2 <= WS_Y, "alias overflow");

__device__ __forceinline__ int tid_opaque() { int t = threadIdx.x; asm volatile("" : "+v"(t)); return t; }
__device__ __forceinline__ unsigned cvt_pk_bf16(float lo, float hi) { unsigned r; asm volatile("v_cvt_pk_bf16_f32 %0, %1, %2" : "=v"(r) : "v"(lo), "v"(hi)); return r; }
__device__ __forceinline__ float bf_lo(unsigned w) { return __uint_as_float(w << 16); }
__device__ __forceinline__ float bf_hi(unsigned w) { return __uint_as_float(w & 0xffff0000u); }
__device__ __forceinline__ float sigmoidf_(float x) { return __builtin_amdgcn_rcpf(1.0f + __expf(-x)); }
__device__ __forceinline__ float siluf_(float x) { return x * sigmoidf_(x); }

namespace pg8 {
constexpr int BM = 256, BK = 64, HALF = 128, HTB = HALF * BK * 2, STAGE_BYTES = 8 * HTB, NXCD = 8, WGM = 8;
__host__ __device__ __forceinline__ int lds_byte(int r, int c) { const int st = (r >> 4) * 2 + (c >> 5), rr = r & 15, cc = c & 31, ob = rr * 64 + cc * 2; return st * 1024 + (ob ^ (((ob >> 9) & 1) << 5)); }
__host__ __device__ __forceinline__ void stage_rc(int b, int& R, int& C) { const int st = b / 1024, sb = b % 1024, swz = sb ^ (((sb >> 9) & 1) << 5); R = (st >> 1) * 16 + swz / 64; C = (st & 1) * 32 + (swz % 64) / 2; }
__host__ __device__ __forceinline__ int perm32(int rho) { const int n = rho >> 4, i = rho & 15; return 8 * (i >> 2) + 4 * n + (i & 3); }

enum { M_PLAIN = 0, M_SILU = 1, M_GLU = 2, M_MUL = 3, M_Y = 4, M_KT = 5, M_VT = 6 };
struct Unit { const char* a; const char* b; int pm, pn, seg, nt; };

struct SegD { const char* A; const char* B; bf16_t* out; int nM, nN, start, ldo, mode, nt; };
struct Sched {
    LAS SegD* tab; float* part; int ns, total, G, c, K;
    int split_seg, total0;
    __device__ __forceinline__ bool next(int i, Unit& u) const {
        int ii = i, base = 0, tot = total, k0 = 0;
        if (split_seg > 0) { const int nr0 = total0 / G; if (i >= nr0) { ii = i - nr0; base = total0; tot = total - total0; k0 = split_seg; } else tot = total0; }
        const int L = ii * G + c; if (L >= tot) return false;
        int w; { const int q = tot / NXCD, r = tot % NXCD, xcd = L % NXCD, off = L / NXCD; w = (xcd < r ? xcd * (q + 1) : r * (q + 1) + (xcd - r) * q) + off; }
        w += base;
        int s = k0;
        for (int k = k0 + 1; k < ns; ++k) if (w >= tab[k].start) s = k;
        s = __builtin_amdgcn_readfirstlane(s);
        const int st = tab[s].start, nm = tab[s].nM, nn = tab[s].nN;
        const int local = w - st, nig = WGM * nn, gid = local / nig, fm = gid * WGM, gsz = (nm - fm) < WGM ? (nm - fm) : WGM;
        u.pm = fm + ((local % nig) % gsz); u.pn = (local % nig) / gsz; u.seg = s; u.nt = tab[s].nt;
        const size_t tstep = (size_t)BM * K * 2;
        u.a = tab[s].A + (size_t)u.pm * tstep; u.b = tab[s].B + (size_t)u.pn * tstep; return true;
    }
};
__device__ __forceinline__ void seg_set(Sched& S, int k, const char* A, const char* B, bf16_t* out, int nM, int nN, int ldo, int mode, int nt = 0) {
    if (threadIdx.x == 0) { LAS SegD* d = S.tab + k; d->A = A; d->B = B; d->out = out; d->nM = nM; d->nN = nN; d->start = S.total; d->ldo = ldo; d->mode = mode; d->nt = nt > 0 ? nt : S.K / BK; }
    S.total += nM * nN; S.ns = k + 1;
}

template <int MODE> __device__ __forceinline__ float pairf(float a, float b) {
    if (MODE == M_SILU) return siluf_(a) * b;
    if (MODE == M_GLU) return a * sigmoidf_(b);
    return a * b;
}
template <int MODE> __device__ __forceinline__ void epi_pair(const f32x4 (&acc)[2][2][4][2], bf16_t* out, int ldo, int row0, int col) {
#pragma unroll
    for (int ai = 0; ai < 2; ++ai)
#pragma unroll
        for (int m = 0; m < 4; ++m) {
            GAS bf16_t* p = (GAS bf16_t*)out + (size_t)(row0 + ai * HALF + m * 16) * ldo + col;
            const f32x4 a0 = acc[ai][0][m][0], a1 = acc[ai][0][m][1], b0 = acc[ai][1][m][0], b1 = acc[ai][1][m][1];
            u32x4 w;
            w.x = cvt_pk_bf16(pairf<MODE>(a0[0], b0[0]), pairf<MODE>(a0[1], b0[1])); w.y = cvt_pk_bf16(pairf<MODE>(a0[2], b0[2]), pairf<MODE>(a0[3], b0[3]));
            w.z = cvt_pk_bf16(pairf<MODE>(a1[0], b1[0]), pairf<MODE>(a1[1], b1[1])); w.w = cvt_pk_bf16(pairf<MODE>(a1[2], b1[2]), pairf<MODE>(a1[3], b1[3]));
            *(GAS u32x4*)p = w;
        }
}
__device__ __forceinline__ void epilogue(const f32x4 (&acc)[2][2][4][2], int pm, int pn, bf16_t* out, float* part, int ldo, int mode, int wr, int wc, int fr, int fq) {
    const int row0 = pm * BM + wr * 64 + fr;
    if (mode == M_SILU) epi_pair<M_SILU>(acc, out, ldo, row0, pn * HALF + wc * 32 + fq * 8);
    else if (mode == M_GLU) epi_pair<M_GLU>(acc, out, ldo, row0, pn * HALF + wc * 32 + fq * 8);
    else if (mode == M_MUL) epi_pair<M_MUL>(acc, out, ldo, row0, pn * HALF + wc * 32 + fq * 8);
    else if (mode == M_KT) {
        const int sh = ldo, NT = 1 << (sh - 4);
#pragma unroll
        for (int ai = 0; ai < 2; ++ai)
#pragma unroll
            for (int m = 0; m < 4; ++m) { const int row = row0 + ai * HALF + m * 16, b = row >> sh, t = row & ((1 << sh) - 1), tile = t >> 4, frp = t & 15;
#pragma unroll
                for (int bj = 0; bj < 2; ++bj) { const int hd = pn * BM + bj * HALF + wc * 32 + fq * 8, h = hd >> 6, dh0 = hd & 63, s2 = dh0 >> 5, qd = (dh0 & 31) >> 3;
                    const f32x4 v0 = acc[ai][bj][m][0], v1 = acc[ai][bj][m][1];
                    u32x4 w; w.x = cvt_pk_bf16(v0[0], v0[1]); w.y = cvt_pk_bf16(v0[2], v0[3]); w.z = cvt_pk_bf16(v1[0], v1[1]); w.w = cvt_pk_bf16(v1[2], v1[3]);
                    *(GAS u32x4*)((GAS bf16_t*)out + ((((size_t)(b * 8 + h) * NT + tile) * 2 + s2) * 64 + qd * 16 + frp) * 8) = w; } }
    }
    else if (mode == M_VT) {
#pragma unroll
        for (int ai = 0; ai < 2; ++ai)
#pragma unroll
            for (int m = 0; m < 4; ++m) { const int hd = row0 + ai * HALF + m * 16, h = hd >> 6, dt = (hd & 63) >> 4, frd = hd & 15;
#pragma unroll
                for (int bj = 0; bj < 2; ++bj) { const int n = pn * BM + bj * HALF + wc * 32 + fq * 8; const bool isc = n >= ML;
                    const int nn = isc ? n - ML : n, sh = isc ? 8 : 12, NT = isc ? 16 : 256, b = nn >> sh, t = nn & ((1 << sh) - 1), tile = t >> 4, qd0 = (t & 15) >> 2;
                    GAS bf16_t* base = isc ? (GAS bf16_t*)part : (GAS bf16_t*)out;
                    GAS bf16_t* p = base + ((((size_t)(b * 8 + h) * NT + tile) * 4 + dt) * 64 + qd0 * 16 + frd) * 4;
                    const f32x4 v0 = acc[ai][bj][m][0], v1 = acc[ai][bj][m][1];
                    u32x2 w0, w1; w0.x = cvt_pk_bf16(v0[0], v0[1]); w0.y = cvt_pk_bf16(v0[2], v0[3]); w1.x = cvt_pk_bf16(v1[0], v1[1]); w1.y = cvt_pk_bf16(v1[2], v1[3]);
                    *(GAS u32x2*)p = w0; *(GAS u32x2*)(p + 64) = w1; } }
    }
    else {
        const int col = pn * BM + wc * 32 + fq * 8;
#pragma unroll
        for (int ai = 0; ai < 2; ++ai)
#pragma unroll
            for (int m = 0; m < 4; ++m) {
                const int row = row0 + ai * HALF + m * 16;
                GAS bf16_t* p = (GAS bf16_t*)out + (size_t)row * ldo + col; float ss = 0.f;
#pragma unroll
                for (int bj = 0; bj < 2; ++bj) { const f32x4 v0 = acc[ai][bj][m][0], v1 = acc[ai][bj][m][1];
                    u32x4 w; w.x = cvt_pk_bf16(v0[0], v0[1]); w.y = cvt_pk_bf16(v0[2], v0[3]); w.z = cvt_pk_bf16(v1[0], v1[1]); w.w = cvt_pk_bf16(v1[2], v1[3]);
                    *(GAS u32x4*)(p + bj * HALF) = w;
                    ss += (v0[0] * v0[0] + v0[1] * v0[1]) + (v0[2] * v0[2] + v0[3] * v0[3]) + (v1[0] * v1[0] + v1[1] * v1[1]) + (v1[2] * v1[2] + v1[3] * v1[3]); }
                if (mode == M_Y) { ss += __shfl_xor(ss, 16); ss += __shfl_xor(ss, 32); if (fq == 0) ((GAS float*)part)[(size_t)row * 16 + pn * 4 + wc] = ss; }
            }
    }
}

__device__ __forceinline__ void gemm_phase(LAS unsigned char* lds, const Sched& S) {
    const int tid = tid_opaque(), wid = __builtin_amdgcn_readfirstlane(tid >> 6), lane = tid & 63, wr = wid >> 2, wc = wid & 3, fr = lane & 15, fq = lane >> 4;
    const int K = S.K;
    unsigned voffA[2], voffB[2];
#pragma unroll
    for (int i = 0; i < 2; ++i) { int R, C; stage_rc(tid * 16 + i * 8192, R, C); const int Rb = (R & ~31) + perm32(R & 31);
        voffA[i] = (unsigned)(R * K + C) * 2u; voffB[i] = (unsigned)(Rb * K + C) * 2u; }
    const size_t kstep = (size_t)(BK * 2);
    const size_t hstep = (size_t)HALF * K * 2;
    const unsigned ldsw = (unsigned)wid * 1024u;
    const int aoff = lds_byte(wr * 64 + fr, fq * 8), boff = lds_byte(wc * 32 + fr, fq * 8);
#define PG8_SA(b, h) (((b) * 2 + (h)) * HTB)
#define PG8_SB(b, h) ((4 + (b) * 2 + (h)) * HTB)
#define PG8_STAGE(bufoff, gbase, voff) do { _Pragma("unroll") for (int _i = 0; _i < 2; ++_i) \
        __builtin_amdgcn_global_load_lds((const unsigned*)((const char*)(gbase) + (voff)[_i]), (LAS unsigned*)(lds + (bufoff) + ldsw + _i * 8192), 16, 0, 0); } while (0)
#define PG8_LDA(dst, b, h) do { _Pragma("unroll") for (int m = 0; m < 4; ++m) _Pragma("unroll") for (int k = 0; k < 2; ++k) dst[m][k] = *(const LAS bf16x8*)(lds + PG8_SA(b, h) + aoff + m * 2048 + k * 1024); } while (0)
#define PG8_LDB(dst, b, h) do { _Pragma("unroll") for (int n = 0; n < 2; ++n) _Pragma("unroll") for (int k = 0; k < 2; ++k) dst[n][k] = *(const LAS bf16x8*)(lds + PG8_SB(b, h) + boff + n * 2048 + k * 1024); } while (0)
#define PG8_MMA(ai, bj, At, Bt) do { __builtin_amdgcn_s_setprio(1); _Pragma("unroll") for (int m = 0; m < 4; ++m) _Pragma("unroll") for (int n = 0; n < 2; ++n) _Pragma("unroll") for (int k = 0; k < 2; ++k) \
        acc[ai][bj][m][n] = __builtin_amdgcn_mfma_f32_16x16x32_bf16(Bt[n][k], At[m][k], acc[ai][bj][m][n], 0, 0, 0); __builtin_amdgcn_s_setprio(0); } while (0)
#define PG8_WAIT_V(n) asm volatile("s_waitcnt vmcnt(" #n ")" ::: "memory")
#define PG8_WAIT_L(n) asm volatile("s_waitcnt lgkmcnt(" #n ")" ::: "memory")
#define PG8_BAR __builtin_amdgcn_s_barrier()
#define PG8_SCHED __builtin_amdgcn_sched_barrier(0)
    Unit cur, nxt; int ui = 0;
    if (!S.next(0, cur)) return;
    f32x4 acc[2][2][4][2];
#pragma unroll
    for (int a = 0; a < 2; ++a)
#pragma unroll
        for (int b = 0; b < 2; ++b)
#pragma unroll
            for (int m = 0; m < 4; ++m)
#pragma unroll
                for (int n = 0; n < 2; ++n) acc[a][b][m][n] = (f32x4){0.f, 0.f, 0.f, 0.f};
    bf16x8 At[4][2], B0[2][2], B1[2][2];
    const char* cA = cur.a; const char* cB = cur.b;
    PG8_STAGE(PG8_SB(0, 0), cB, voffB); PG8_STAGE(PG8_SB(0, 1), cB + hstep, voffB); PG8_STAGE(PG8_SA(0, 0), cA, voffA); PG8_STAGE(PG8_SA(0, 1), cA + hstep, voffA);
    if (wr == 1) PG8_BAR;
    PG8_WAIT_V(2); PG8_BAR;
    PG8_STAGE(PG8_SB(1, 0), cB + kstep, voffB); PG8_STAGE(PG8_SA(1, 0), cA + kstep, voffA); PG8_STAGE(PG8_SB(1, 1), cB + hstep + kstep, voffB);
    PG8_WAIT_V(6); PG8_BAR;
    for (;;) {
        const bool has_next = S.next(ui + 1, nxt);
        const char* nA = has_next ? nxt.a : cA; const char* nB = has_next ? nxt.b : cB;
        const int nt = cur.nt;
        for (int t = 0; t < nt; t += 2) {
            const bool last = (t == nt - 2);
            const char* a1 = cA + (size_t)(t + 1) * kstep;
            const char* a2 = last ? nA : cA + (size_t)(t + 2) * kstep; const char* b2 = last ? nB : cB + (size_t)(t + 2) * kstep;
            const char* a3 = a2 + kstep; const char* b3 = b2 + kstep;
            PG8_LDB(B0, 0, 0); PG8_LDB(B1, 0, 1); PG8_SCHED; PG8_LDA(At, 0, 0); PG8_STAGE(PG8_SA(1, 1), a1 + hstep, voffA);
            PG8_WAIT_V(8); PG8_WAIT_L(0); PG8_BAR; PG8_MMA(0, 0, At, B0); PG8_MMA(0, 1, At, B1); PG8_BAR; PG8_SCHED;
            PG8_LDA(At, 0, 1); PG8_STAGE(PG8_SB(0, 0), b2, voffB); PG8_STAGE(PG8_SB(0, 1), b2 + hstep, voffB); PG8_STAGE(PG8_SA(0, 0), a2, voffA);
            PG8_WAIT_V(8); PG8_WAIT_L(0); PG8_BAR; PG8_MMA(1, 0, At, B0); PG8_MMA(1, 1, At, B1); PG8_BAR; PG8_SCHED;
            PG8_LDB(B0, 1, 0); PG8_LDB(B1, 1, 1); PG8_SCHED; PG8_LDA(At, 1, 0); PG8_STAGE(PG8_SA(0, 1), a2 + hstep, voffA);
            PG8_WAIT_V(8); PG8_WAIT_L(0); PG8_BAR; PG8_MMA(0, 0, At, B0); PG8_MMA(0, 1, At, B1); PG8_BAR; PG8_SCHED;
            PG8_LDA(At, 1, 1); PG8_STAGE(PG8_SB(1, 0), b3, voffB); PG8_STAGE(PG8_SB(1, 1), b3 + hstep, voffB); PG8_STAGE(PG8_SA(1, 0), a3, voffA);
            PG8_WAIT_V(8); PG8_WAIT_L(0); PG8_BAR; PG8_MMA(1, 0, At, B0); PG8_MMA(1, 1, At, B1); PG8_BAR; PG8_SCHED;
        }
        if (wr == 0) PG8_BAR;
        {
            bf16_t* o = S.tab[cur.seg].out; const int ldo = S.tab[cur.seg].ldo, mode = S.tab[cur.seg].mode;
            epilogue(acc, cur.pm, cur.pn, o, S.part, ldo, mode, wr, wc, fr, fq);
        }
        if (!has_next) break;
#pragma unroll
        for (int a = 0; a < 2; ++a)
#pragma unroll
            for (int b = 0; b < 2; ++b)
#pragma unroll
                for (int m = 0; m < 4; ++m)
#pragma unroll
                    for (int n = 0; n < 2; ++n) acc[a][b][m][n] = (f32x4){0.f, 0.f, 0.f, 0.f};
        cur = nxt; cA = nA; cB = nB; ++ui;
        if (wr == 1) PG8_BAR;
    }
    PG8_WAIT_V(0);
    PG8_BAR;
#undef PG8_SA
#undef PG8_SB
#undef PG8_STAGE
#undef PG8_LDA
#undef PG8_LDB
#undef PG8_MMA
#undef PG8_WAIT_V
#undef PG8_WAIT_L
#undef PG8_BAR
#undef PG8_SCHED
}
}

__device__ __forceinline__ int rowmap(int n, int mapmode) {
    if (mapmode == 0) return n;
    if (mapmode == 1) { const int j = n < DFF ? n : n - DFF; return (j >> 7) * 256 + (n < DFF ? 0 : 128) + (j & 127); }
    if (mapmode == 2) { if (n >= 1024) return n; const int j = n & 511; return (j >> 7) * 256 + (n < 512 ? 0 : 128) + (j & 127); }
    if (n < 1024) return 2048 + n; { const int j = (n - 1024) & 1023; return (j >> 7) * 256 + (n < 2048 ? 0 : 128) + (j & 127); }
}
__device__ __forceinline__ void convert_tile(LAS unsigned char* lds, const float* src, bf16_t* dst, int K, int N, int mapmode, int tile) {
    LAS float* T = (LAS float*)lds;
    const int tid = tid_opaque(), ntn = N >> 7, tk = tile / ntn, tn = tile % ntn, k0 = tk * 128, n0 = tn * 128;
    { const int r = tid >> 5, c4 = (tid & 31) * 4; f32x4 v[8];
#pragma unroll
      for (int h = 0; h < 8; ++h) v[h] = *(const f32x4*)(src + (size_t)(k0 + r + 16 * h) * N + n0 + c4);
#pragma unroll
      for (int h = 0; h < 8; ++h) { LAS float* t = T + (r + 16 * h) * 129 + c4; t[0] = v[h][0]; t[1] = v[h][1]; t[2] = v[h][2]; t[3] = v[h][3]; } }
    __syncthreads();
    { const int n = tid >> 2, kc = (tid & 3) * 32; bf16_t* drow = dst + (size_t)rowmap(n0 + n, mapmode) * K + k0 + kc;
#pragma unroll
      for (int q = 0; q < 4; ++q) { float v[8];
#pragma unroll
          for (int j = 0; j < 8; ++j) v[j] = T[(kc + q * 8 + j) * 129 + n];
          u32x4 w; w.x = cvt_pk_bf16(v[0], v[1]); w.y = cvt_pk_bf16(v[2], v[3]); w.z = cvt_pk_bf16(v[4], v[5]); w.w = cvt_pk_bf16(v[6], v[7]);
          *(u32x4*)(drow + q * 8) = w; } }
    __syncthreads();
}
__device__ __forceinline__ void modgemv_task(LAS unsigned char* lds, const float* c, const float* c_ctx, const float* w_mod, const float* b_mod, float* mod, int task) {
    LAS float* sc = (LAS float*)lds;
    LAS float* red = (LAS float*)(lds + 9 * 1024 * 4);
    const int tid = threadIdx.x, wv = tid >> 6, lane = tid & 63, l = task / 72, cgp = task % 72;
    for (int i = tid; i < 9 * 1024; i += NTHREADS) { const int r = i >> 10, k = i & 1023; const float v = r < 8 ? c[r * 1024 + k] : c_ctx[k]; sc[i] = siluf_(v); }
    __syncthreads();
    float acc[9][2];
#pragma unroll
    for (int r = 0; r < 9; ++r) { acc[r][0] = 0.f; acc[r][1] = 0.f; }
    const float* wp = w_mod + (size_t)l * 1024 * NMODW + (size_t)(wv * 128) * NMODW + cgp * 128 + lane * 2;
    for (int k4 = 0; k4 < 32; ++k4) {
        f32x2 w[4];
#pragma unroll
        for (int j = 0; j < 4; ++j) w[j] = *(const f32x2*)(wp + (size_t)(k4 * 4 + j) * NMODW);
#pragma unroll
        for (int r = 0; r < 9; ++r) { const f32x4 s = *(const LAS f32x4*)(sc + r * 1024 + wv * 128 + k4 * 4);
#pragma unroll
            for (int j = 0; j < 4; ++j) { acc[r][0] += s[j] * w[j][0]; acc[r][1] += s[j] * w[j][1]; } }
    }
#pragma unroll
    for (int r = 0; r < 9; ++r) { red[(wv * 18 + r * 2 + 0) * 64 + lane] = acc[r][0]; red[(wv * 18 + r * 2 + 1) * 64 + lane] = acc[r][1]; }
    __syncthreads();
    for (int i = tid; i < 9 * 128; i += NTHREADS) { const int r = i >> 7, cc = i & 127, ln = cc >> 1, e = cc & 1; float s = 0.f;
#pragma unroll
        for (int w8 = 0; w8 < 8; ++w8) s += red[(w8 * 18 + r * 2 + e) * 64 + ln];
        const int n = cgp * 128 + cc; mod[((size_t)l * 9 + r) * NMODW + n] = s + b_mod[l * NMODW + n]; }
    __syncthreads();
}

struct NormP {
    const void* xin_lat; const float* xin_ctx; void* xout;
    int xin_bf, xout_bf;
    const bf16_t* YC;
    const bf16_t* Y; const float* part;
    const float* mod_post; const float* gpost; float coef; int kpost;
    const float* mod_pre; const float* gpre; bf16_t* H; int kpre;
    int nrows, do_post, do_pre;
};
__device__ __forceinline__ void unpack8(const u32x4 w, f32x4& lo, f32x4& hi) { lo = (f32x4){bf_lo(w.x), bf_hi(w.x), bf_lo(w.y), bf_hi(w.y)}; hi = (f32x4){bf_lo(w.z), bf_hi(w.z), bf_lo(w.w), bf_hi(w.w)}; }
__device__ __forceinline__ u32x4 pack8(const f32x4 lo, const f32x4 hi) { u32x4 w; w.x = cvt_pk_bf16(lo[0], lo[1]); w.y = cvt_pk_bf16(lo[2], lo[3]); w.z = cvt_pk_bf16(hi[0], hi[1]); w.w = cvt_pk_bf16(hi[2], hi[3]); return w; }
__device__ __forceinline__ void norm_phase(const NormP& P) {
    const int tid_ = tid_opaque(), lane = tid_ & 63, wv = __builtin_amdgcn_readfirstlane(tid_ >> 6);
    const int ngrp = P.nrows >> 2;
    for (int grp = blockIdx.x * 8 + wv; grp < ngrp; grp += gridDim.x * 8) {
        const int row0 = grp * 4; const bool isctx = row0 >= ML; const int crow = isctx ? 8 : (row0 >> 12);
        f32x4 x[4][2][2];
        if (!isctx && P.xin_bf) { const bf16_t* xb = (const bf16_t*)P.xin_lat + (size_t)row0 * D;
#pragma unroll
            for (int r = 0; r < 4; ++r)
#pragma unroll
                for (int i = 0; i < 2; ++i) { const u32x4 w = *(const u32x4*)(xb + (size_t)r * D + i * 512 + lane * 8); unpack8(w, x[r][i][0], x[r][i][1]); }
        } else { const float* xp = isctx ? P.xin_ctx + (size_t)(row0 - ML) * D : (const float*)P.xin_lat + (size_t)row0 * D;
#pragma unroll
            for (int r = 0; r < 4; ++r)
#pragma unroll
                for (int i = 0; i < 2; ++i) { const float* p = xp + (size_t)r * D + i * 512 + lane * 8; x[r][i][0] = *(const f32x4*)p; x[r][i][1] = *(const f32x4*)(p + 4); } }
        if (P.do_post) {
            u32x4 yw[4][2]; float rstd[4];
            if (isctx && P.YC) {
#pragma unroll
                for (int r = 0; r < 4; ++r) { float ss = 0.f;
#pragma unroll
                    for (int i = 0; i < 2; ++i) { const bf16_t* yp = P.YC + (size_t)(row0 - ML + r) * D + i * 512 + lane * 8; f32x4 a0 = (f32x4){0.f, 0.f, 0.f, 0.f}, a1 = a0;
#pragma unroll
                        for (int j = 0; j < 4; ++j) { f32x4 l, h; unpack8(*(const u32x4*)(yp + (size_t)j * MC * D), l, h); a0 += l; a1 += h; }
                        ss += ((a0[0] * a0[0] + a0[1] * a0[1]) + (a0[2] * a0[2] + a0[3] * a0[3])) + ((a1[0] * a1[0] + a1[1] * a1[1]) + (a1[2] * a1[2] + a1[3] * a1[3])); yw[r][i] = pack8(a0, a1); }
#pragma unroll
                    for (int o = 32; o >= 1; o >>= 1) ss += __shfl_xor(ss, o);
                    rstd[r] = rsqrtf(ss * (1.0f / D) + EPS) * P.coef; }
            } else {
#pragma unroll
                for (int r = 0; r < 4; ++r)
#pragma unroll
                    for (int i = 0; i < 2; ++i) yw[r][i] = *(const u32x4*)(P.Y + (size_t)(row0 + r) * D + i * 512 + lane * 8);
#pragma unroll
                for (int r = 0; r < 4; ++r) { const f32x4* pp = (const f32x4*)(P.part + (size_t)(row0 + r) * 16); const f32x4 p0 = pp[0], p1 = pp[1], p2 = pp[2], p3 = pp[3];
                    const float ssy = ((p0[0] + p0[1]) + (p0[2] + p0[3])) + ((p1[0] + p1[1]) + (p1[2] + p1[3])) + ((p2[0] + p2[1]) + (p2[2] + p2[3])) + ((p3[0] + p3[1]) + (p3[2] + p3[3]));
                    rstd[r] = rsqrtf(ssy * (1.0f / D) + EPS) * P.coef; }
            }
            __builtin_amdgcn_sched_barrier(0);
            const float* gate = P.mod_post + ((size_t)crow * 9 + 3 * P.kpost + 2) * D;
#pragma unroll
            for (int i = 0; i < 2; ++i) { const int col = i * 512 + lane * 8;
                const f32x4 gg0 = *(const f32x4*)(gate + col) * *(const f32x4*)(P.gpost + col), gg1 = *(const f32x4*)(gate + col + 4) * *(const f32x4*)(P.gpost + col + 4);
#pragma unroll
                for (int r = 0; r < 4; ++r) { f32x4 yl, yh; unpack8(yw[r][i], yl, yh); x[r][i][0] += gg0 * (yl * rstd[r]); x[r][i][1] += gg1 * (yh * rstd[r]); } }
            if (!isctx) {
                if (P.xout_bf) {
#pragma unroll
                    for (int r = 0; r < 4; ++r)
#pragma unroll
                        for (int i = 0; i < 2; ++i) *(u32x4*)((bf16_t*)P.xout + (size_t)(row0 + r) * D + i * 512 + lane * 8) = pack8(x[r][i][0], x[r][i][1]);
                } else {
#pragma unroll
                    for (int r = 0; r < 4; ++r)
#pragma unroll
                        for (int i = 0; i < 2; ++i) { float* p = (float*)P.xout + (size_t)(row0 + r) * D + i * 512 + lane * 8; *(f32x4*)p = x[r][i][0]; *(f32x4*)(p + 4) = x[r][i][1]; } } }
        }
        __builtin_amdgcn_sched_barrier(0);
        if (P.do_pre) {
            float rs[4];
#pragma unroll
            for (int r = 0; r < 4; ++r) { float ss = 0.f;
#pragma unroll
                for (int i = 0; i < 2; ++i)
#pragma unroll
                    for (int h = 0; h < 2; ++h) { const f32x4 v = x[r][i][h]; ss += (v[0] * v[0] + v[1] * v[1]) + (v[2] * v[2] + v[3] * v[3]); }
#pragma unroll
                for (int o = 32; o >= 1; o >>= 1) ss += __shfl_xor(ss, o);
                rs[r] = rsqrtf(ss * (1.0f / D) + EPS); }
            const float* sh = P.mod_pre + ((size_t)crow * 9 + 3 * P.kpre) * D; const float* scl = sh + D;
            __builtin_amdgcn_sched_barrier(0);
#pragma unroll
            for (int i = 0; i < 2; ++i) { const int col = i * 512 + lane * 8;
                const f32x4 gs0 = *(const f32x4*)(P.gpre + col) * (1.0f + *(const f32x4*)(scl + col)), gs1 = *(const f32x4*)(P.gpre + col + 4) * (1.0f + *(const f32x4*)(scl + col + 4));
                const f32x4 t0 = *(const f32x4*)(sh + col), t1 = *(const f32x4*)(sh + col + 4);
#pragma unroll
                for (int r = 0; r < 4; ++r) *(u32x4*)(P.H + (size_t)(row0 + r) * D + col) = pack8((x[r][i][0] * rs[r]) * gs0 + t0, (x[r][i][1] * rs[r]) * gs1 + t1); }
        }
    }
}

template <int CTRL> __device__ __forceinline__ float dpp_f(float x) { return __builtin_bit_cast(float, __builtin_amdgcn_mov_dpp(__builtin_bit_cast(int, x), CTRL, 0xf, 0xf, true)); }
__device__ __forceinline__ float half_wave_sum(float v) {
    v += dpp_f<0xB1>(v); v += dpp_f<0x4E>(v); v += dpp_f<0x141>(v); v += dpp_f<0x128>(v);
    v += __builtin_bit_cast(float, __builtin_amdgcn_ds_swizzle(__builtin_bit_cast(int, v), 0x401F));
    return v;
}
template <int I, int K> struct ConvK { static __device__ __forceinline__ void run(f32x2 (&acc)[32], const f32x2 (&w)[31], const f32x2 x) {
    constexpr int o = I - K;
    if constexpr (o >= 0 && o < 32) acc[o] = w[K] * x + acc[o];
    if constexpr (K + 1 < 31) ConvK<I, K + 1>::run(acc, w, x); } };
template <int I> struct ConvI { static __device__ __forceinline__ void run(f32x2 (&acc)[32], const f32x2 (&w)[31], const LAS unsigned char* p) {
    const unsigned xv = *(const LAS unsigned*)(p + I * 1024); const f32x2 x = (f32x2){bf_lo(xv), bf_hi(xv)};
    ConvK<I, 0>::run(acc, w, x);
    if constexpr (I + 1 < 62) ConvI<I + 1>::run(acc, w, p); } };
template <int O> struct ConvOut { static __device__ __forceinline__ void run(const f32x2 (&acc)[32], const f32x2 lg, const f32x2 lb, bf16_t* yp) {
    const f32x2 a = acc[O];
    const float s = half_wave_sum(a[0] + a[1]), q = half_wave_sum(a[0] * a[0] + a[1] * a[1]);
    const float mu = s * (1.0f / 64.0f); float var = q * (1.0f / 64.0f) - mu * mu; var = var < 0.f ? 0.f : var; const float rstd = rsqrtf(var + EPS);
    const float v0 = (a[0] - mu) * rstd * lg[0] + lb[0], v1 = (a[1] - mu) * rstd * lg[1] + lb[1];
    *(unsigned*)(yp + (size_t)O * D) = cvt_pk_bf16(siluf_(v0), siluf_(v1));
    if constexpr (O + 1 < 32) ConvOut<O + 1>::run(acc, lg, lb, yp); } };
__device__ __forceinline__ void conv_tile(LAS unsigned char* lds, const bf16_t* UA, const float* dw_w, const float* dw_b, const float* ln_g, const float* ln_b, bf16_t* YAB, int tile) {
    const int tid = tid_opaque(), b = tile >> 6, t0 = (tile & 63) * 64;
    {   u32x4 v[12];
#pragma unroll
        for (int j = 0; j < 12; ++j) { const int idx = tid + j * NTHREADS, rr = idx >> 6, c16 = idx & 63, t = t0 - 15 + rr; v[j] = (u32x4){0u, 0u, 0u, 0u};
            if (rr < 94 && t >= 0 && t < SEQ) v[j] = *(const u32x4*)(UA + (size_t)(b * SEQ + t) * LDU + c16 * 8); }
#pragma unroll
        for (int j = 0; j < 12; ++j) { const int idx = tid + j * NTHREADS, rr = idx >> 6, c16 = idx & 63; if (rr < 94) *(LAS u32x4*)(lds + rr * 1024 + c16 * 16) = v[j]; } }
    __syncthreads();
    const int cp = tid & 255, th = tid >> 8;
    f32x2 w[31];
#pragma unroll
    for (int k = 0; k < 31; ++k) w[k] = *(const f32x2*)(dw_w + k * 512 + 2 * cp);
    const f32x2 bias = *(const f32x2*)(dw_b + 2 * cp);
    f32x2 acc[32];
#pragma unroll
    for (int o = 0; o < 32; ++o) acc[o] = bias;
    ConvI<0>::run(acc, w, lds + th * 32 * 1024 + cp * 4);
    const f32x2 lg = *(const f32x2*)(ln_g + 2 * cp), lb = *(const f32x2*)(ln_b + 2 * cp);
    ConvOut<0>::run(acc, lg, lb, YAB + (size_t)(b * SEQ + t0 + th * 32) * D + 2 * cp);
    __syncthreads();
}

#define MFMA16(a, b, c) __builtin_amdgcn_mfma_f32_16x16x32_bf16((a), (b), (c), 0, 0, 0)
constexpr int RING_V = 9 * 8192, ATT_LB = 2 * 9 * 8192;
constexpr float SC2 = 0.125f * 1.44269504f;
__device__ __forceinline__ void ring_load(LAS unsigned char* lds, const bf16_t* kbase, const bf16_t* vbase, int Rlo, int Rhi) {
    const int tid = threadIdx.x, n = (Rhi - Rlo + 1) * 512;
    for (int i0 = 0; i0 < n; i0 += 4 * NTHREADS) {
        u32x4 kk[4], vv[4];
#pragma unroll
        for (int j = 0; j < 4; ++j) { const int i = i0 + j * NTHREADS + tid; if (i < n) { const int R = Rlo + (i >> 9), c = i & 511;
            kk[j] = *(const u32x4*)(kbase + (size_t)R * 4096 + c * 8); vv[j] = *(const u32x4*)(vbase + (size_t)R * 4096 + c * 8); } }
#pragma unroll
        for (int j = 0; j < 4; ++j) { const int i = i0 + j * NTHREADS + tid; if (i < n) { const int R = Rlo + (i >> 9), c = i & 511, sl = R % 9;
            *(LAS u32x4*)(lds + sl * 8192 + c * 16) = kk[j]; *(LAS u32x4*)(lds + RING_V + sl * 8192 + c * 16) = vv[j]; } }
    }
}
__device__ __forceinline__ int clampi(int v, int lo, int hi) { return v < lo ? lo : (v > hi ? hi : v); }
__device__ __forceinline__ void attn_block(LAS unsigned char* lds, const bf16_t* UA, const bf16_t* KT, const bf16_t* KC, const bf16_t* VT, const bf16_t* VC, const float* rpb,
                                           u32x2* O2, f32x2* MS2, bf16_t* YAB, int blk) {
    const int tid = tid_opaque(), wv = tid >> 6, lane = tid & 63, fr = lane & 15, quad = lane >> 4;
    const int rq = blk & 3, h = (blk >> 2) & 7, b = blk >> 5, r0 = rq * 16;
    const f32x4 z4 = (f32x4){0.f, 0.f, 0.f, 0.f};
    const int ct = wv & 3, c0 = ct * 16, cb = clampi(c0 - 8, 0, 32), c = c0 + fr, cs = clampi(c - 8, 0, 48);
    const bf16_t* qbase = UA + ((size_t)b * SEQ + c) * LDU + 512 + h * 64 + quad * 8;
    u32x2* o2p = O2 + ((size_t)blk * 64 * 4) * 64 + lane; f32x2* msp = MS2 + (size_t)blk * 64 * 64 + lane;
    {
        LAS unsigned char* Lk = lds; LAS unsigned char* Lv = lds + 32768;
        const u32x4* gk = (const u32x4*)(KC + (size_t)(b * 8 + h) * 16 * 2 * 64 * 8); const u32x4* gv = (const u32x4*)(VC + (size_t)(b * 8 + h) * 16 * 4 * 64 * 4);
        u32x4 tk[4], tv[4];
#pragma unroll
        for (int j = 0; j < 4; ++j) { tk[j] = gk[tid + j * NTHREADS]; tv[j] = gv[tid + j * NTHREADS]; }
#pragma unroll
        for (int j = 0; j < 4; ++j) { ((LAS u32x4*)Lk)[tid + j * NTHREADS] = tk[j];
            const int u = (tid + j * NTHREADS) * 2, ln = u & 63, dt = (u >> 6) & 3, t = u >> 8;
            LAS unsigned char* d = Lv + ((((t >> 1) * 4 + dt) * 64 + ln) * 16) + (t & 1) * 8;
            *(LAS u32x2*)d = (u32x2){tv[j].x, tv[j].y}; *(LAS u32x2*)(d + 16) = (u32x2){tv[j].z, tv[j].w}; }
        __syncthreads();
        bf16x8 q0 = *(const bf16x8*)(qbase + (size_t)(r0 + (wv >> 2)) * 64 * LDU), q1 = *(const bf16x8*)(qbase + (size_t)(r0 + (wv >> 2)) * 64 * LDU + 32);
        for (int p = 0; p < 8; ++p) {
            const int it = p * 8 + wv, rn = r0 + (p < 7 ? 2 * p + 2 : 0) + (wv >> 2);
            const bf16x8 qn0 = *(const bf16x8*)(qbase + (size_t)rn * 64 * LDU), qn1 = *(const bf16x8*)(qbase + (size_t)rn * 64 * LDU + 32);
            f32x4 o2[4] = {z4, z4, z4, z4}; float m2 = -1e30f, s2 = 0.f;
            f32x4 sx[16];
#pragma unroll
            for (int t = 0; t < 16; ++t) { const bf16x8 k0 = *(const LAS bf16x8*)(Lk + ((t * 2 + 0) * 64 + lane) * 16), k1 = *(const LAS bf16x8*)(Lk + ((t * 2 + 1) * 64 + lane) * 16);
                sx[t] = MFMA16(k1, q1, MFMA16(k0, q0, z4)); }
            {   f32x4 vm = sx[0];
#pragma unroll
                for (int t = 1; t < 16; ++t) vm = __builtin_elementwise_max(vm, sx[t]);
                m2 = fmaxf(fmaxf(vm[0], vm[1]), fmaxf(vm[2], vm[3])); m2 = fmaxf(m2, __shfl_xor(m2, 16)); m2 = fmaxf(m2, __shfl_xor(m2, 32));
                m2 *= SC2;
                f32x4 vs = z4;
#pragma unroll
                for (int t = 0; t < 16; ++t) { f32x4 e = sx[t] * SC2 - m2; e[0] = __builtin_amdgcn_exp2f(e[0]); e[1] = __builtin_amdgcn_exp2f(e[1]); e[2] = __builtin_amdgcn_exp2f(e[2]); e[3] = __builtin_amdgcn_exp2f(e[3]); sx[t] = e; vs += e; }
                s2 = (vs[0] + vs[1]) + (vs[2] + vs[3]); s2 += __shfl_xor(s2, 16); s2 += __shfl_xor(s2, 32); }
#pragma unroll
            for (int kb = 0; kb < 8; ++kb) {
                u32x4 pw; pw.x = cvt_pk_bf16(sx[2 * kb][0], sx[2 * kb][1]); pw.y = cvt_pk_bf16(sx[2 * kb][2], sx[2 * kb][3]); pw.z = cvt_pk_bf16(sx[2 * kb + 1][0], sx[2 * kb + 1][1]); pw.w = cvt_pk_bf16(sx[2 * kb + 1][2], sx[2 * kb + 1][3]);
                const bf16x8 pf = __builtin_bit_cast(bf16x8, pw);
#pragma unroll
                for (int dt = 0; dt < 4; ++dt) o2[dt] = MFMA16(*(const LAS bf16x8*)(Lv + ((kb * 4 + dt) * 64 + lane) * 16), pf, o2[dt]);
            }
            const float i2 = 1.0f / s2;
#pragma unroll
            for (int dt = 0; dt < 4; ++dt) { u32x2 w; w.x = cvt_pk_bf16(o2[dt][0] * i2, o2[dt][1] * i2); w.y = cvt_pk_bf16(o2[dt][2] * i2, o2[dt][3] * i2); o2p[(size_t)(it * 4 + dt) * 64] = w; }
            msp[(size_t)it * 64] = (f32x2){m2, s2};
            q0 = qn0; q1 = qn1;
        }
    }
    __syncthreads();
    {
        LAS float* Lb = (LAS float*)(lds + ATT_LB);
        if (tid < 465) Lb[tid] = rpb[h * 465 + tid] * 1.44269504f;
        const bf16_t* kbase = KT + (size_t)(b * 8 + h) * 256 * 2 * 64 * 8;
        const bf16_t* vbase = VT + (size_t)(b * 8 + h) * 256 * 4 * 64 * 4;
        bf16x8 q0 = *(const bf16x8*)(qbase + (size_t)(r0 + (wv >> 2)) * 64 * LDU), q1 = *(const bf16x8*)(qbase + (size_t)(r0 + (wv >> 2)) * 64 * LDU + 32);
        int cjo[2][4]; f32x4 madd[2];
#pragma unroll
        for (int T = 0; T < 2; ++T)
#pragma unroll
            for (int j = 0; j < 4; ++j) { const int kc = cb + T * 16 + quad * 4 + j; cjo[T][j] = clampi(kc - c + 15, 0, 30); madd[T][j] = ((unsigned)(kc - cs) < 16u) ? 0.f : -1e30f; }
        int prev_hi = clampi(r0 + 1 - 4, 0, 56) + 7;
        ring_load(lds, kbase, vbase, clampi(r0 - 4, 0, 56), prev_hi);
        __syncthreads();
        for (int p = 0; p < 8; ++p) {
            const int nhi = p < 7 ? clampi(r0 + 2 * p + 3 - 4, 0, 56) + 7 : prev_hi, nnew = nhi - prev_hi;
            u32x4 pk[2], pv[2];
#pragma unroll
            for (int j = 0; j < 2; ++j) if (j < nnew) { const size_t go = (size_t)(prev_hi + 1 + j) * 4096 + tid * 8; pk[j] = *(const u32x4*)(kbase + go); pv[j] = *(const u32x4*)(vbase + go); }
            const int it = p * 8 + wv, r = r0 + 2 * p + (wv >> 2), rs = clampi(r - 4, 0, 56), rn = r0 + (p < 7 ? 2 * p + 2 : 0) + (wv >> 2);
            const bf16x8 qn0 = *(const bf16x8*)(qbase + (size_t)rn * 64 * LDU), qn1 = *(const bf16x8*)(qbase + (size_t)rn * 64 * LDU + 32);
            u32x2 o2w[4];
#pragma unroll
            for (int dt = 0; dt < 4; ++dt) o2w[dt] = o2p[(size_t)(it * 4 + dt) * 64];
            const f32x2 ms = msp[(size_t)it * 64];
            f32x4 o1[4] = {z4, z4, z4, z4}; float m1 = -1e30f, s1 = 0.f;
            f32x4 sw[8][2];
#pragma unroll
            for (int i = 0; i < 8; ++i) { const LAS unsigned char* Ks = lds + ((rs + i) % 9) * 8192;
#pragma unroll
                for (int T = 0; T < 2; ++T) { const int col = cb + T * 16 + fr; const LAS unsigned char* kp = Ks + (((col >> 4) * 2) * 64 + quad * 16 + (col & 15)) * 16;
                    const bf16x8 k0 = *(const LAS bf16x8*)kp, k1 = *(const LAS bf16x8*)(kp + 1024);
                    sw[i][T] = MFMA16(k1, q1, MFMA16(k0, q0, z4)); } }
            {   f32x4 vm = (f32x4){-1e30f, -1e30f, -1e30f, -1e30f};
#pragma unroll
                for (int i = 0; i < 8; ++i) { const LAS float* rrow = Lb + (rs + i - r + 7) * 31;
#pragma unroll
                    for (int T = 0; T < 2; ++T) { const f32x4 bv = (f32x4){rrow[cjo[T][0]], rrow[cjo[T][1]], rrow[cjo[T][2]], rrow[cjo[T][3]]};
                        const f32x4 l = sw[i][T] * SC2 + (bv + madd[T]); sw[i][T] = l; vm = __builtin_elementwise_max(vm, l); } }
                m1 = fmaxf(fmaxf(vm[0], vm[1]), fmaxf(vm[2], vm[3])); m1 = fmaxf(m1, __shfl_xor(m1, 16)); m1 = fmaxf(m1, __shfl_xor(m1, 32));
                f32x4 vs = z4;
#pragma unroll
                for (int i = 0; i < 8; ++i)
#pragma unroll
                    for (int T = 0; T < 2; ++T) { f32x4 e = sw[i][T] - m1; e[0] = __builtin_amdgcn_exp2f(e[0]); e[1] = __builtin_amdgcn_exp2f(e[1]); e[2] = __builtin_amdgcn_exp2f(e[2]); e[3] = __builtin_amdgcn_exp2f(e[3]); sw[i][T] = e; vs += e; }
                s1 = (vs[0] + vs[1]) + (vs[2] + vs[3]); s1 += __shfl_xor(s1, 16); s1 += __shfl_xor(s1, 32); }
            const int colv = cb + quad * 4;
#pragma unroll
            for (int i = 0; i < 8; ++i) {
                u32x4 pw; pw.x = cvt_pk_bf16(sw[i][0][0], sw[i][0][1]); pw.y = cvt_pk_bf16(sw[i][0][2], sw[i][0][3]); pw.z = cvt_pk_bf16(sw[i][1][0], sw[i][1][1]); pw.w = cvt_pk_bf16(sw[i][1][2], sw[i][1][3]);
                const bf16x8 pf = __builtin_bit_cast(bf16x8, pw);
                const LAS unsigned char* vp = lds + RING_V + ((rs + i) % 9) * 8192 + (((colv >> 4) * 4) * 64 + ((colv & 15) >> 2) * 16 + fr) * 8;
#pragma unroll
                for (int dt = 0; dt < 4; ++dt) { const s16x4 lo = *(const LAS s16x4*)(vp + dt * 512), hi = *(const LAS s16x4*)(vp + dt * 512 + 2048);
                    o1[dt] = MFMA16(__builtin_shufflevector(lo, hi, 0, 1, 2, 3, 4, 5, 6, 7), pf, o1[dt]); }
            }
            const float m2 = ms[0], s2 = ms[1], mm = fmaxf(m1, m2), a1 = __builtin_amdgcn_exp2f(m1 - mm), a2 = __builtin_amdgcn_exp2f(m2 - mm) * s2, inv = 1.0f / (s1 * a1 + a2), f1 = a1 * inv, f2 = a2 * inv;
            bf16_t* op = YAB + ((size_t)b * SEQ + r * 64 + c) * D + 512 + h * 64 + quad * 4;
#pragma unroll
            for (int dt = 0; dt < 4; ++dt) { u32x2 w; w.x = cvt_pk_bf16(o1[dt][0] * f1 + bf_lo(o2w[dt].x) * f2, o1[dt][1] * f1 + bf_hi(o2w[dt].x) * f2);
                w.y = cvt_pk_bf16(o1[dt][2] * f1 + bf_lo(o2w[dt].y) * f2, o1[dt][3] * f1 + bf_hi(o2w[dt].y) * f2);
                *(u32x2*)(op + dt * 16) = w; }
            q0 = qn0; q1 = qn1;
            __syncthreads();
#pragma unroll
            for (int j = 0; j < 2; ++j) if (j < nnew) { const int sl = (prev_hi + 1 + j) % 9; *(LAS u32x4*)(lds + sl * 8192 + tid * 16) = pk[j]; *(LAS u32x4*)(lds + RING_V + sl * 8192 + tid * 16) = pv[j]; }
            prev_hi = nhi;
            __syncthreads();
        }
    }
}

__device__ __forceinline__ void conv3_phase(const bf16_t* CX, const bf16_t* BG, const float* cw, bf16_t* S) {
    constexpr int RUN = 8;
    for (int task = blockIdx.x * NTHREADS + threadIdx.x; task < (ML / RUN) * 128; task += gridDim.x * NTHREADS) {
        const int c8 = (task & 127) * 8, tok0 = (task >> 7) * RUN, t0 = tok0 & (SEQ - 1);
        f32x4 w[3][2];
#pragma unroll
        for (int k = 0; k < 3; ++k) { w[k][0] = *(const f32x4*)(cw + k * D + c8); w[k][1] = *(const f32x4*)(cw + k * D + c8 + 4); }
        const u32x4 z = (u32x4){0u, 0u, 0u, 0u};
        u32x4 rows[RUN + 2], bg[RUN];
        rows[0] = t0 > 0 ? *(const u32x4*)(CX + (size_t)(tok0 - 1) * D + c8) : z;
#pragma unroll
        for (int j = 0; j < RUN; ++j) { rows[j + 1] = *(const u32x4*)(CX + (size_t)(tok0 + j) * D + c8); bg[j] = *(const u32x4*)(BG + (size_t)(tok0 + j) * D + c8); }
        rows[RUN + 1] = (t0 + RUN < SEQ) ? *(const u32x4*)(CX + (size_t)(tok0 + RUN) * D + c8) : z;
#pragma unroll
        for (int j = 0; j < RUN; ++j) { f32x4 pl, ph, cl, ch, nl, nh, bl, bh;
            unpack8(rows[j], pl, ph); unpack8(rows[j + 1], cl, ch); unpack8(rows[j + 2], nl, nh); unpack8(bg[j], bl, bh);
            const f32x4 rl = bl * (w[0][0] * pl + w[1][0] * cl + w[2][0] * nl), rh = bh * (w[0][1] * ph + w[1][1] * ch + w[2][1] * nh);
            *(u32x4*)(S + (size_t)(tok0 + j) * D + c8) = pack8(rl, rh); }
    }
}

#define XB_TMO      128
#define XB_XCNT(j)  (256  + 64 * (j))
#define XB_XSUB(j)  (1280 + 64 * (j))
#define XB_XGEN(j)  (2304 + 64 * (j))
#define XB_TOP      3328
#define XB_TOPGEN   3392
#define XCD_BAR_WORDS 3456
#define XB_SPIN_CAP (1u << 20)
__device__ __forceinline__ unsigned xb_ld(unsigned* p)              { return __hip_atomic_load(p, __ATOMIC_RELAXED, __HIP_MEMORY_SCOPE_AGENT); }
__device__ __forceinline__ unsigned xb_add(unsigned* p, unsigned v) { return __hip_atomic_fetch_add(p, v, __ATOMIC_RELAXED, __HIP_MEMORY_SCOPE_AGENT); }
__device__ __forceinline__ unsigned xb_xcc_id() { return (unsigned)__builtin_amdgcn_s_getreg((3 << 11) | 20) & 0xFu; }
#define XB_SPIN(cond, bar) do { unsigned _sp = 0; while (cond) { __builtin_amdgcn_s_sleep(1); \
    if ((++_sp & 255u) == 0u) { if (xb_ld(&(bar)[XB_TMO])) break; if (_sp > XB_SPIN_CAP) { atomicAdd(&(bar)[XB_TMO], 1u); break; } } } } while (0)
struct XcdBarrier { unsigned* bar; unsigned x; volatile LAS unsigned* st; };
__device__ __forceinline__ XcdBarrier xcd_barrier_post(unsigned* bar, volatile LAS unsigned* st) {
    XcdBarrier b; b.bar = bar; b.x = xb_xcc_id(); b.st = st;
    if (threadIdx.x == 0) (void)xb_add(&bar[XB_XCNT(b.x)], 1u);
    return b;
}
__device__ __forceinline__ void xcd_barrier_complete(unsigned* bar, unsigned x, unsigned& nloc, unsigned& nx) {
    const unsigned G = gridDim.x * gridDim.y * gridDim.z;
    unsigned sum, cnt, mine, sp = 0u;
    for (;;) {
        sum = 0u; cnt = 0u; mine = 0u;
#pragma unroll
        for (unsigned j = 0; j < 16; ++j) { const unsigned c = xb_ld(&bar[XB_XCNT(j)]); sum += c; cnt += (c > 0u) ? 1u : 0u; mine = (j == x) ? c : mine; }
        if (sum == G) break;
        __builtin_amdgcn_s_sleep(1);
        if ((++sp & 255u) == 0u) { if (xb_ld(&bar[XB_TMO])) break; if (sp > XB_SPIN_CAP) { atomicAdd(&bar[XB_TMO], 1u); break; } }
    }
    nloc = mine > 0u ? mine : 1u; nx = cnt > 0u ? cnt : 1u;
}
__device__ __forceinline__ void xcd_barrier(const XcdBarrier& b) {
    asm volatile("s_waitcnt vmcnt(0)" ::: "memory");
    __syncthreads();
    if (threadIdx.x == 0) {
        unsigned* bar = b.bar;
        __builtin_amdgcn_s_waitcnt(0);
        unsigned nloc = b.st[0], nx = b.st[1];
        if (nloc == 0u) { xcd_barrier_complete(bar, b.x, nloc, nx); b.st[0] = nloc; b.st[1] = nx; }
        const unsigned old = xb_add(&bar[XB_XSUB(b.x)], 1u);
        const unsigned gen = old / nloc;
        if (old + 1u == (gen + 1u) * nloc) {
            __builtin_amdgcn_fence(__ATOMIC_RELEASE, "agent");
            asm volatile("s_waitcnt vmcnt(0)" ::: "memory");
            const unsigned og = xb_add(&bar[XB_TOP], 1u);
            const unsigned tg = og / nx;
            if (og + 1u == (tg + 1u) * nx) xb_add(&bar[XB_TOPGEN], 1u);
            else XB_SPIN(xb_ld(&bar[XB_TOPGEN]) == tg, bar);
            __builtin_amdgcn_fence(__ATOMIC_ACQUIRE, "agent");
            xb_add(&bar[XB_XGEN(b.x)], 1u);
            asm volatile("s_waitcnt vmcnt(0)" ::: "memory");
        } else {
            XB_SPIN(xb_ld(&bar[XB_XGEN(b.x)]) == gen, bar);
            __builtin_amdgcn_fence(__ATOMIC_ACQUIRE, "agent");
            asm volatile("s_waitcnt vmcnt(0)" ::: "memory");
        }
    }
    __syncthreads();
}

struct Args { const float* in[21]; float* out; unsigned char* ws; int ph_lo, ph_hi; };
constexpr int LDS_BYTES = 150 * 1024;

__device__ __forceinline__ pg8::Sched sched_init(LAS unsigned char* lds, int K, float* part) {
    pg8::Sched S; S.tab = (LAS pg8::SegD*)(lds + pg8::STAGE_BYTES); S.part = part; S.ns = 0; S.total = 0; S.G = gridDim.x; S.c = blockIdx.x; S.K = K; S.split_seg = 0; S.total0 = 0; return S;
}
__device__ __forceinline__ void ffn_gu(LAS unsigned char* lds, unsigned char* ws, int wi, int nM) {
    pg8::Sched S = sched_init(lds, D, nullptr);
    pg8::seg_set(S, 0, (const char*)(ws + WS_H), (const char*)(ws + WS_WGU + (size_t)wi * SZ_WGU), (bf16_t*)(ws + WS_ACT), nM, 22, DFF, pg8::M_SILU);
    __syncthreads();
    pg8::gemm_phase(lds, S);
}
__device__ __forceinline__ void gemm_y(LAS unsigned char* lds, unsigned char* ws, const char* A, const char* Bt, int K, int nM) {
    pg8::Sched S = sched_init(lds, K, (float*)(ws + WS_PART));
    pg8::seg_set(S, 0, A, Bt, (bf16_t*)(ws + WS_Y), nM, 4, D, pg8::M_Y);
    __syncthreads();
    pg8::gemm_phase(lds, S);
}

__global__ void __launch_bounds__(NTHREADS, 2) fwd_kernel(Args args) {
    extern __shared__ __attribute__((aligned(16))) unsigned char lds_raw[];
    LAS unsigned char* lds = (LAS unsigned char*)lds_raw;
    cg::grid_group grid = cg::this_grid();
    unsigned char* ws = args.ws;
    const int lo = args.ph_lo, hi = args.ph_hi;
#define IN(k) (lo <= (k) && (k) < hi)
#define REP(k) for (int _r = 0; _r < ((k) == DUP_PHASE ? 2 : 1); ++_r)
#define SEAM(k) do { if (IN(k) && IN((k) + 1)) xcd_barrier(xbar); } while (0)
    const float* x_in = args.in[0]; const float* ctx_in = args.in[2];
    const float* norm_g = args.in[6];
    float* mod = (float*)(ws + WS_MOD);
    bf16_t* xres = (bf16_t*)(ws + WS_XB);
    bf16_t* yab = (bf16_t*)args.out;
    const int G = gridDim.x, bid = blockIdx.x;
    volatile LAS unsigned* xst = (volatile LAS unsigned*)(lds + LDS_BYTES - 16);
    if (threadIdx.x == 0) { xst[0] = 0u; xst[1] = 0u; }
    __syncthreads();
    XcdBarrier xbar; xbar.bar = (unsigned*)(ws + WS_CTL); xbar.x = 0; xbar.st = xst;
    if (hi - lo > 1) xbar = xcd_barrier_post((unsigned*)(ws + WS_CTL), xst);

    if (IN(0)) REP(0) {
        for (int task = bid; task < 144; task += G) modgemv_task(lds, args.in[1], args.in[3], args.in[4], args.in[5], mod, task);
        {
            constexpr int NMAT = 12;
            int tstart[NMAT + 1]; { int t = 0;
#pragma unroll
                for (int mi = 0; mi < NMAT; ++mi) { tstart[mi] = t; const int K = (mi >= 4 && mi < 8) ? DFF : D, N = mi < 4 ? 2 * DFF : (mi < 8 ? D : (mi == 8 ? 2560 : (mi == 10 ? 3072 : D))); t += (K >> 7) * (N >> 7); } tstart[NMAT] = t; }
            for (int tt = G - 1 - bid; tt < tstart[NMAT]; tt += G) {
                int mi = 0, t0 = 0;
#pragma unroll
                for (int k = 1; k < NMAT; ++k) if (tt >= tstart[k]) { mi = k; t0 = tstart[k]; }
                const float* src; bf16_t* dst; int K, N, mm;
                if (mi < 4) { const int l = mi >> 1, f = mi & 1; src = args.in[f ? 9 : 7] + (size_t)l * D * 2 * DFF; dst = (bf16_t*)(ws + WS_WGU + (size_t)mi * SZ_WGU); K = D; N = 2 * DFF; mm = 1; }
                else if (mi < 8) { const int l = (mi - 4) >> 1, f = (mi - 4) & 1; src = args.in[f ? 10 : 8] + (size_t)l * DFF * D; dst = (bf16_t*)(ws + WS_WDN + (size_t)(mi - 4) * SZ_WDN); K = DFF; N = D; mm = 0; }
                else if (mi == 8) { src = args.in[11]; dst = (bf16_t*)(ws + WS_WEVIN); K = D; N = 2560; mm = 2; }
                else if (mi == 9) { src = args.in[12]; dst = (bf16_t*)(ws + WS_WEVOUT); K = D; N = D; mm = 0; }
                else if (mi == 10) { src = args.in[18]; dst = (bf16_t*)(ws + WS_WODIN); K = D; N = 3072; mm = 3; }
                else { src = args.in[20]; dst = (bf16_t*)(ws + WS_WODOUT); K = D; N = D; mm = 0; }
                convert_tile(lds, src, dst, K, N, mm, tt - t0);
            }
        }
    }
    SEAM(0);
    if (IN(1)) REP(1) { NormP P{}; P.xin_lat = x_in; P.xin_ctx = ctx_in; P.do_post = 0; P.do_pre = 1; P.mod_pre = mod; P.kpre = 0; P.gpre = norm_g + 0 * D; P.H = (bf16_t*)(ws + WS_H); P.nrows = MT; norm_phase(P); }
    SEAM(1);
    if (IN(2)) REP(2) ffn_gu(lds, ws, 0, MT / 256);
    SEAM(2);
    if (IN(3)) REP(3) {
        pg8::Sched S = sched_init(lds, DFF, (float*)(ws + WS_PART));
        const char* A = (const char*)(ws + WS_ACT); const char* B = (const char*)(ws + WS_WDN);
        pg8::seg_set(S, 0, A, B, (bf16_t*)(ws + WS_Y), ML / 256, 4, D, pg8::M_Y);
        if ((ML / 256 * 4) % G == 0) { S.split_seg = 1; S.total0 = S.total; }
        const int ks[4] = {0, 768, 1536, 2176}, kt[4] = {12, 12, 10, 10};
#pragma unroll
        for (int j = 0; j < 4; ++j) pg8::seg_set(S, 1 + j, A + (size_t)ML * DFF * 2 + ks[j] * 2, B + ks[j] * 2, (bf16_t*)args.out + (size_t)j * MC * D, MC / 256, 4, D, pg8::M_PLAIN, kt[j]);
        __syncthreads();
        pg8::gemm_phase(lds, S);
    }
    SEAM(3);
    if (IN(4)) REP(4) { NormP P{}; P.xin_lat = x_in; P.xin_ctx = ctx_in; P.xout = xres; P.xin_bf = 0; P.xout_bf = 1; P.YC = (const bf16_t*)args.out; P.Y = (const bf16_t*)(ws + WS_Y); P.part = (const float*)(ws + WS_PART);
        P.do_post = 1; P.mod_post = mod; P.kpost = 0; P.gpost = norm_g + 1 * D; P.coef = 0.5f;
        P.do_pre = 1; P.mod_pre = mod; P.kpre = 1; P.gpre = norm_g + 2 * D; P.H = (bf16_t*)(ws + WS_H); P.nrows = MT; norm_phase(P); }
    SEAM(4);
    if (IN(5)) REP(5) {
        pg8::Sched S = sched_init(lds, D, (float*)(ws + WS_VC)); const char* Hb = (const char*)(ws + WS_H); const char* W = (const char*)(ws + WS_WEVIN);
        pg8::seg_set(S, 0, Hb, W, (bf16_t*)(ws + WS_UA), 128, 4, LDU, pg8::M_GLU);
        pg8::seg_set(S, 1, Hb, W + (size_t)1024 * D * 2, (bf16_t*)(ws + WS_UA) + 512, 128, 2, LDU, pg8::M_PLAIN);
        pg8::seg_set(S, 2, Hb, W + (size_t)1536 * D * 2, (bf16_t*)(ws + WS_KT), 128, 2, 12, pg8::M_KT);
        pg8::seg_set(S, 3, Hb + (size_t)ML * D * 2, W + (size_t)1536 * D * 2, (bf16_t*)(ws + WS_KC), 8, 2, 8, pg8::M_KT);
        pg8::seg_set(S, 4, W + (size_t)2048 * D * 2, Hb, (bf16_t*)(ws + WS_VT), 2, MT / 256, 0, pg8::M_VT);
        __syncthreads();
        pg8::gemm_phase(lds, S);
    }
    SEAM(5);
    if (IN(6)) {
        for (int t = bid; t < 512 * (DUP_PHASE == 6 ? 2 : 1); t += G) conv_tile(lds, (const bf16_t*)(ws + WS_UA), args.in[13], args.in[14], args.in[15], args.in[16], yab, t & 511);
        for (int blk = bid; blk < 256 * (DUP_PHASE == 66 ? 2 : 1); blk += G)
            attn_block(lds, (const bf16_t*)(ws + WS_UA), (const bf16_t*)(ws + WS_KT), (const bf16_t*)(ws + WS_KC), (const bf16_t*)(ws + WS_VT), (const bf16_t*)(ws + WS_VC), args.in[17], (u32x2*)(ws + WS_H), (f32x2*)(ws + WS_Y), yab, blk & 255);
    }
    SEAM(6);
    if (IN(7)) REP(7) gemm_y(lds, ws, (const char*)yab, (const char*)(ws + WS_WEVOUT), D, ML / 256);
    SEAM(7);
    if (IN(8)) REP(8) { NormP P{}; P.xin_lat = xres; P.xin_ctx = ctx_in; P.xout = xres; P.xin_bf = 1; P.xout_bf = 1; P.Y = (const bf16_t*)(ws + WS_Y); P.part = (const float*)(ws + WS_PART);
        P.do_post = 1; P.mod_post = mod; P.kpost = 1; P.gpost = norm_g + 3 * D; P.coef = 1.0f;
        P.do_pre = 1; P.mod_pre = mod; P.kpre = 2; P.gpre = norm_g + 4 * D; P.H = (bf16_t*)(ws + WS_H); P.nrows = ML; norm_phase(P); }
    SEAM(8);
    if (IN(9)) REP(9) ffn_gu(lds, ws, 1, ML / 256);
    SEAM(9);
    if (IN(10)) REP(10) gemm_y(lds, ws, (const char*)(ws + WS_ACT), (const char*)(ws + WS_WDN + 1 * SZ_WDN), DFF, ML / 256);
    SEAM(10);
    const float* mod1 = mod + (size_t)9 * NMODW; const float* ng1 = norm_g + 6 * D;
    if (IN(11)) REP(11) { NormP P{}; P.xin_lat = xres; P.xin_ctx = ctx_in; P.xout = xres; P.xin_bf = 1; P.xout_bf = 1; P.Y = (const bf16_t*)(ws + WS_Y); P.part = (const float*)(ws + WS_PART);
        P.do_post = 1; P.mod_post = mod; P.kpost = 2; P.gpost = norm_g + 5 * D; P.coef = 0.5f;
        P.do_pre = 1; P.mod_pre = mod1; P.kpre = 0; P.gpre = ng1 + 0 * D; P.H = (bf16_t*)(ws + WS_H); P.nrows = ML; norm_phase(P); }
    SEAM(11);
    if (IN(12)) REP(12) ffn_gu(lds, ws, 2, ML / 256);
    SEAM(12);
    if (IN(13)) REP(13) gemm_y(lds, ws, (const char*)(ws + WS_ACT), (const char*)(ws + WS_WDN + 2 * SZ_WDN), DFF, ML / 256);
    SEAM(13);
    if (IN(14)) REP(14) { NormP P{}; P.xin_lat = xres; P.xin_ctx = ctx_in; P.xout = xres; P.xin_bf = 1; P.xout_bf = 1; P.Y = (const bf16_t*)(ws + WS_Y); P.part = (const float*)(ws + WS_PART);
        P.do_post = 1; P.mod_post = mod1; P.kpost = 0; P.gpost = ng1 + 1 * D; P.coef = 0.5f;
        P.do_pre = 1; P.mod_pre = mod1; P.kpre = 1; P.gpre = ng1 + 2 * D; P.H = (bf16_t*)(ws + WS_H); P.nrows = ML; norm_phase(P); }
    SEAM(14);
    if (IN(15)) REP(15) {
        pg8::Sched S = sched_init(lds, D, nullptr); const char* Hb = (const char*)(ws + WS_H); const char* W = (const char*)(ws + WS_WODIN);
        pg8::seg_set(S, 0, Hb, W, (bf16_t*)(ws + WS_CX), 128, 8, D, pg8::M_MUL);
        pg8::seg_set(S, 1, Hb, W + (size_t)2048 * D * 2, (bf16_t*)(ws + WS_BG), 128, 4, D, pg8::M_PLAIN);
        __syncthreads();
        pg8::gemm_phase(lds, S);
    }
    SEAM(15);
    if (IN(16)) REP(16) conv3_phase((const bf16_t*)(ws + WS_CX), (const bf16_t*)(ws + WS_BG), args.in[19], yab);
    SEAM(16);
    if (IN(17)) REP(17) gemm_y(lds, ws, (const char*)yab, (const char*)(ws + WS_WODOUT), D, ML / 256);
    SEAM(17);
    if (IN(18)) REP(18) { NormP P{}; P.xin_lat = xres; P.xin_ctx = ctx_in; P.xout = xres; P.xin_bf = 1; P.xout_bf = 1; P.Y = (const bf16_t*)(ws + WS_Y); P.part = (const float*)(ws + WS_PART);
        P.do_post = 1; P.mod_post = mod1; P.kpost = 1; P.gpost = ng1 + 3 * D; P.coef = 1.0f;
        P.do_pre = 1; P.mod_pre = mod1; P.kpre = 2; P.gpre = ng1 + 4 * D; P.H = (bf16_t*)(ws + WS_H); P.nrows = ML; norm_phase(P); }
    SEAM(18);
    if (IN(19)) REP(19) ffn_gu(lds, ws, 3, ML / 256);
    SEAM(19);
    if (IN(20)) REP(20) gemm_y(lds, ws, (const char*)(ws + WS_ACT), (const char*)(ws + WS_WDN + 3 * SZ_WDN), DFF, ML / 256);
    SEAM(20);
    if (IN(21)) REP(21) { NormP P{}; P.xin_lat = xres; P.xin_ctx = ctx_in; P.xout = args.out; P.xin_bf = 1; P.xout_bf = 0; P.Y = (const bf16_t*)(ws + WS_Y); P.part = (const float*)(ws + WS_PART);
        P.do_post = 1; P.mod_post = mod1; P.kpost = 2; P.gpost = ng1 + 5 * D; P.coef = 0.5f; P.do_pre = 0; P.nrows = ML; norm_phase(P); }
    if (hi > NPH + 1) grid.sync();
#undef IN
#undef SEAM
}

extern "C" void kernel_launch(void* const* d_in, const int* in_sizes, int n_in, void* d_out, int out_size, void* d_ws, size_t ws_size, hipStream_t stream) {
    static int grid = 0;
    if (grid == 0) {
        if (n_in != 21 || out_size != ML * D || ws_size < WS_END) { fprintf(stderr, "kernel_launch: unexpected shapes (n_in %d out %d ws %zu need %zu)\n", n_in, out_size, ws_size, (size_t)WS_END); grid = -1; return; }
        int dev = 0, cus = 0, per_cu = 0;
        (void)hipGetDevice(&dev); (void)hipDeviceGetAttribute(&cus, hipDeviceAttributeMultiprocessorCount, dev);
        if (hipFuncSetAttribute((const void*)fwd_kernel, hipFuncAttributeMaxDynamicSharedMemorySize, LDS_BYTES) != hipSuccess) { fprintf(stderr, "kernel_launch: hipFuncSetAttribute failed\n"); grid = -1; return; }
        if (hipOccupancyMaxActiveBlocksPerMultiprocessor(&per_cu, (const void*)fwd_kernel, NTHREADS, LDS_BYTES) != hipSuccess || per_cu < 1) { fprintf(stderr, "kernel_launch: occupancy query says %d\n", per_cu); per_cu = 1; }
        (void)hipGetLastError();
        grid = cus * 1;
    }
    if (grid < 0) return;
    Args a{};
    for (int i = 0; i < 21; ++i) a.in[i] = (const float*)d_in[i];
    a.out = (float*)d_out; a.ws = (unsigned char*)d_ws;
#if ONE_LAUNCH
    (void)hipMemsetAsync((unsigned char*)d_ws + WS_CTL, 0, CTL_BYTES, stream);
    a.ph_lo = 0; a.ph_hi = NPH;
    void* kargs[] = {&a};
    hipError_t e = hipLaunchCooperativeKernel((const void*)fwd_kernel, dim3(grid), dim3(NTHREADS), kargs, LDS_BYTES, stream);
    if (e != hipSuccess) fprintf(stderr, "cooperative launch failed: %s (grid %d)\n", hipGetErrorString(e), grid);
#else
    for (int p = 0; p < NPH; ++p) { a.ph_lo = p; a.ph_hi = p + 1; hipLaunchKernelGGL(fwd_kernel, dim3(grid), dim3(NTHREADS), LDS_BYTES, stream, a); }
#endif
}
```

```cpp
#include <hip/hip_runtime.h>
#include <hip/hip_cooperative_groups.h>
#include <cstdio>
namespace cg = cooperative_groups;

#ifndef ONE_LAUNCH
#define ONE_LAUNCH 1
#endif

#ifndef DUP_PHASE
#define DUP_PHASE -1
#endif
#define LAS __attribute__((address_space(3)))
typedef unsigned short bf16_t;
typedef short bf16x8 __attribute__((ext_vector_type(8)));
typedef short s16x4 __attribute__((ext_vector_type(4)));
typedef float f32x4 __attribute__((ext_vector_type(4)));
typedef float f32x2 __attribute__((ext_vector_type(2)));
typedef unsigned u32x4 __attribute__((ext_vector_type(4)));
typedef unsigned u32x2 __attribute__((ext_vector_type(2)));

constexpr int D = 1024, NB = 8, SEQ = 4096, ML = NB * SEQ, CTXL = 256, MC = NB * CTXL, MT = ML + MC, DFF = 2816;
constexpr int NMODW = 9 * D;
constexpr float EPS = 1e-6f;
constexpr int NTHREADS = 512;
constexpr int NPH = 22;

constexpr size_t SZ_WGU = (size_t)2 * DFF * D * 2, SZ_WDN = (size_t)D * DFF * 2;
constexpr size_t WS_WGU = 0;
constexpr size_t WS_WDN = WS_WGU + 4 * SZ_WGU;
constexpr size_t WS_WEVIN = WS_WDN + 4 * SZ_WDN;
constexpr size_t WS_WEVOUT = WS_WEVIN + (size_t)2560 * D * 2;
constexpr size_t WS_WODIN = WS_WEVOUT + (size_t)D * D * 2;
constexpr size_t WS_WODOUT = WS_WODIN + (size_t)3072 * D * 2;
constexpr size_t WS_MOD = WS_WODOUT + (size_t)D * D * 2;
constexpr size_t WS_PART = WS_MOD + (size_t)2 * 9 * NMODW * 4;
constexpr size_t WS_H = WS_PART + (size_t)MT * 16 * 4;
constexpr size_t WS_ACT = WS_H + (size_t)MT * D * 2;
constexpr size_t WS_Y = WS_ACT + (size_t)MT * DFF * 2;
constexpr size_t WS_XB = WS_Y + (size_t)MT * D * 2;
constexpr size_t WS_YAB = WS_XB;
constexpr size_t WS_CTL = WS_YAB + (size_t)ML * D * 2;
constexpr size_t CTL_BYTES = 16384;
constexpr size_t WS_END = WS_CTL + CTL_BYTES;
constexpr int LDU = 1024;
constexpr size_t WS_UA = WS_ACT;
constexpr size_t WS_KT = WS_UA + (size_t)ML * LDU * 2;
constexpr size_t WS_KC = WS_KT + (size_t)ML * 512 * 2;
constexpr size_t WS_VT = WS_KC + (size_t)MC * 512 * 2;
constexpr size_t WS_VC = WS_VT + (size_t)ML * 512 * 2;
constexpr size_t WS_CX = WS_ACT;
constexpr size_t WS_BG = WS_CX + (size_t)ML * D * 2;
static_assert(WS_VC + (size_t)MC * 512 * 2 <= WS_Y, "alias overflow");
static_assert(WS_BG + (size_t)ML * D * 2 <= WS_Y, "alias overflow");

__device__ __forceinline__ int tid_opaque() { int t = threadIdx.x; asm volatile("" : "+v"(t)); return t; }
__device__ __forceinline__ unsigned cvt_pk_bf16(float lo, float hi) { unsigned r; asm volatile("v_cvt_pk_bf16_f32 %0, %1, %2" : "=v"(r) : "v"(lo), "v"(hi)); return r; }
__device__ __forceinline__ float bf_lo(unsigned w) { return __uint_as_float(w << 16); }
__device__ __forceinline__ float bf_hi(unsigned w) { return __uint_as_float(w & 0xffff0000u); }
__device__ __forceinline__ float sigmoidf_(float x) { return __builtin_amdgcn_rcpf(1.0f + __expf(-x)); }
__device__ __forceinline__ float siluf_(float x) { return x * sigmoidf_(x); }

namespace pg8 {
constexpr int BM = 256, BK = 64, HALF = 128, HTB = HALF * BK * 2, STAGE_BYTES = 8 * HTB, NXCD = 8, WGM = 8;
__host__ __device__ __forceinline__ int lds_byte(int r, int c) { const int st = (r >> 4) * 2 + (c >> 5), rr = r & 15, cc = c & 31, ob = rr * 64 + cc * 2; return st * 1024 + (ob ^ (((ob >> 9) & 1) << 5)); }
__host__ __device__ __forceinline__ void stage_rc(int b, int& R, int& C) { const int st = b / 1024, sb = b % 1024, swz = sb ^ (((sb >> 9) & 1) << 5); R = (st >> 1) * 16 + swz / 64; C = (st & 1) * 32 + (swz % 64) / 2; }
__host__ __device__ __forceinline__ int perm32(int rho) { const int n = rho >> 4, i = rho & 15; return 8 * (i >> 2) + 4 * n + (i & 3); }

enum { M_PLAIN = 0, M_SILU = 1, M_GLU = 2, M_MUL = 3, M_Y = 4, M_KT = 5, M_VT = 6 };
struct Unit { const char* a; const char* b; int pm, pn, seg, nt; };

struct SegD { const char* A; const char* B; bf16_t* out; int nM, nN, start, ldo, mode, nt; };
struct Sched {
    LAS SegD* tab; float* part; int ns, total, G, c, K;
    int split_seg, total0;
    __device__ __forceinline__ bool next(int i, Unit& u) const {
        int ii = i, base = 0, tot = total, k0 = 0;
        if (split_seg > 0) { const int nr0 = total0 / G; if (i >= nr0) { ii = i - nr0; base = total0; tot = total - total0; k0 = split_seg; } else tot = total0; }
        const int L = ii * G + c; if (L >= tot) return false;
        int w; { const int q = tot / NXCD, r = tot % NXCD, xcd = L % NXCD, off = L / NXCD; w = (xcd < r ? xcd * (q + 1) : r * (q + 1) + (xcd - r) * q) + off; }
        w += base;
        int s = k0;
        for (int k = k0 + 1; k < ns; ++k) if (w >= tab[k].start) s = k;
        s = __builtin_amdgcn_readfirstlane(s);
        const int st = tab[s].start, nm = tab[s].nM, nn = tab[s].nN;
        const int local = w - st, nig = WGM * nn, gid = local / nig, fm = gid * WGM, gsz = (nm - fm) < WGM ? (nm - fm) : WGM;
        u.pm = fm + ((local % nig) % gsz); u.pn = (local % nig) / gsz; u.seg = s; u.nt = tab[s].nt;
        const size_t tstep = (size_t)BM * K * 2;
        u.a = tab[s].A + (size_t)u.pm * tstep; u.b = tab[s].B + (size_t)u.pn * tstep; return true;
    }
};
__device__ __forceinline__ void seg_set(Sched& S, int k, const char* A, const char* B, bf16_t* out, int nM, int nN, int ldo, int mode, int nt = 0) {
    if (threadIdx.x == 0) { LAS SegD* d = S.tab + k; d->A = A; d->B = B; d->out = out; d->nM = nM; d->nN = nN; d->start = S.total; d->ldo = ldo; d->mode = mode; d->nt = nt > 0 ? nt : S.K / BK; }
    S.total += nM * nN; S.ns = k + 1;
}

template <int MODE> __device__ __forceinline__ float pairf(float a, float b) {
    if (MODE == M_SILU) return siluf_(a) * b;
    if (MODE == M_GLU) return a * sigmoidf_(b);
    return a * b;
}
template <int MODE> __device__ __forceinline__ void epi_pair(const f32x4 (&acc)[2][2][4][2], bf16_t* out, int ldo, int row0, int col) {
#pragma unroll
    for (int ai = 0; ai < 2; ++ai)
#pragma unroll
        for (int m = 0; m < 4; ++m) {
            bf16_t* p = out + (size_t)(row0 + ai * HALF + m * 16) * ldo + col;
            const f32x4 a0 = acc[ai][0][m][0], a1 = acc[ai][0][m][1], b0 = acc[ai][1][m][0], b1 = acc[ai][1][m][1];
            u32x4 w;
            w.x = cvt_pk_bf16(pairf<MODE>(a0[0], b0[0]), pairf<MODE>(a0[1], b0[1])); w.y = cvt_pk_bf16(pairf<MODE>(a0[2], b0[2]), pairf<MODE>(a0[3], b0[3]));
            w.z = cvt_pk_bf16(pairf<MODE>(a1[0], b1[0]), pairf<MODE>(a1[1], b1[1])); w.w = cvt_pk_bf16(pairf<MODE>(a1[2], b1[2]), pairf<MODE>(a1[3], b1[3]));
            *(u32x4*)p = w;
        }
}
__device__ __forceinline__ void epilogue(const f32x4 (&acc)[2][2][4][2], int pm, int pn, bf16_t* out, float* part, int ldo, int mode, int wr, int wc, int fr, int fq) {
    const int row0 = pm * BM + wr * 64 + fr;
    if (mode == M_SILU) epi_pair<M_SILU>(acc, out, ldo, row0, pn * HALF + wc * 32 + fq * 8);
    else if (mode == M_GLU) epi_pair<M_GLU>(acc, out, ldo, row0, pn * HALF + wc * 32 + fq * 8);
    else if (mode == M_MUL) epi_pair<M_MUL>(acc, out, ldo, row0, pn * HALF + wc * 32 + fq * 8);
    else if (mode == M_KT) {
        const int sh = ldo, NT = 1 << (sh - 4);
#pragma unroll
        for (int ai = 0; ai < 2; ++ai)
#pragma unroll
            for (int m = 0; m < 4; ++m) { const int row = row0 + ai * HALF + m * 16, b = row >> sh, t = row & ((1 << sh) - 1), tile = t >> 4, frp = t & 15;
#pragma unroll
                for (int bj = 0; bj < 2; ++bj) { const int hd = pn * BM + bj * HALF + wc * 32 + fq * 8, h = hd >> 6, dh0 = hd & 63, s2 = dh0 >> 5, qd = (dh0 & 31) >> 3;
                    const f32x4 v0 = acc[ai][bj][m][0], v1 = acc[ai][bj][m][1];
                    u32x4 w; w.x = cvt_pk_bf16(v0[0], v0[1]); w.y = cvt_pk_bf16(v0[2], v0[3]); w.z = cvt_pk_bf16(v1[0], v1[1]); w.w = cvt_pk_bf16(v1[2], v1[3]);
                    *(u32x4*)(out + ((((size_t)(b * 8 + h) * NT + tile) * 2 + s2) * 64 + qd * 16 + frp) * 8) = w; } }
    }
    else if (mode == M_VT) {
#pragma unroll
        for (int ai = 0; ai < 2; ++ai)
#pragma unroll
            for (int m = 0; m < 4; ++m) { const int hd = row0 + ai * HALF + m * 16, h = hd >> 6, dt = (hd & 63) >> 4, frd = hd & 15;
#pragma unroll
                for (int bj = 0; bj < 2; ++bj) { const int n = pn * BM + bj * HALF + wc * 32 + fq * 8; const bool isc = n >= ML;
                    const int nn = isc ? n - ML : n, sh = isc ? 8 : 12, NT = isc ? 16 : 256, b = nn >> sh, t = nn & ((1 << sh) - 1), tile = t >> 4, qd0 = (t & 15) >> 2;
                    bf16_t* base = isc ? (bf16_t*)part : out;
                    bf16_t* p = base + ((((size_t)(b * 8 + h) * NT + tile) * 4 + dt) * 64 + qd0 * 16 + frd) * 4;
                    const f32x4 v0 = acc[ai][bj][m][0], v1 = acc[ai][bj][m][1];
                    u32x2 w0, w1; w0.x = cvt_pk_bf16(v0[0], v0[1]); w0.y = cvt_pk_bf16(v0[2], v0[3]); w1.x = cvt_pk_bf16(v1[0], v1[1]); w1.y = cvt_pk_bf16(v1[2], v1[3]);
                    *(u32x2*)p = w0; *(u32x2*)(p + 64) = w1; } }
    }
    else {
        const int col = pn * BM + wc * 32 + fq * 8;
#pragma unroll
        for (int ai = 0; ai < 2; ++ai)
#pragma unroll
            for (int m = 0; m < 4; ++m) {
                const int row = row0 + ai * HALF + m * 16;
                bf16_t* p = out + (size_t)row * ldo + col; float ss = 0.f;
#pragma unroll
                for (int bj = 0; bj < 2; ++bj) { const f32x4 v0 = acc[ai][bj][m][0], v1 = acc[ai][bj][m][1];
                    u32x4 w; w.x = cvt_pk_bf16(v0[0], v0[1]); w.y = cvt_pk_bf16(v0[2], v0[3]); w.z = cvt_pk_bf16(v1[0], v1[1]); w.w = cvt_pk_bf16(v1[2], v1[3]);
                    *(u32x4*)(p + bj * HALF) = w;
                    ss += (v0[0] * v0[0] + v0[1] * v0[1]) + (v0[2] * v0[2] + v0[3] * v0[3]) + (v1[0] * v1[0] + v1[1] * v1[1]) + (v1[2] * v1[2] + v1[3] * v1[3]); }
                if (mode == M_Y) { ss += __shfl_xor(ss, 16); ss += __shfl_xor(ss, 32); if (fq == 0) part[(size_t)row * 16 + pn * 4 + wc] = ss; }
            }
    }
}

__device__ __forceinline__ void gemm_phase(LAS unsigned char* lds, const Sched& S) {
    const int tid = tid_opaque(), wid = __builtin_amdgcn_readfirstlane(tid >> 6), lane = tid & 63, wr = wid >> 2, wc = wid & 3, fr = lane & 15, fq = lane >> 4;
    const int K = S.K;
    unsigned voffA[2], voffB[2];
#pragma unroll
    for (int i = 0; i < 2; ++i) { int R, C; stage_rc(tid * 16 + i * 8192, R, C); const int Rb = (R & ~31) + perm32(R & 31);
        voffA[i] = (unsigned)(R * K + C) * 2u; voffB[i] = (unsigned)(Rb * K + C) * 2u; }
    const size_t kstep = (size_t)(BK * 2);
    const size_t hstep = (size_t)HALF * K * 2;
    const unsigned ldsw = (unsigned)wid * 1024u;
    const int aoff = lds_byte(wr * 64 + fr, fq * 8), boff = lds_byte(wc * 32 + fr, fq * 8);
#define PG8_SA(b, h) (((b) * 2 + (h)) * HTB)
#define PG8_SB(b, h) ((4 + (b) * 2 + (h)) * HTB)
#define PG8_STAGE(bufoff, gbase, voff) do { _Pragma("unroll") for (int _i = 0; _i < 2; ++_i) \
        __builtin_amdgcn_global_load_lds((const unsigned*)((const char*)(gbase) + (voff)[_i]), (LAS unsigned*)(lds + (bufoff) + ldsw + _i * 8192), 16, 0, 0); } while (0)
#define PG8_LDA(dst, b, h) do { _Pragma("unroll") for (int m = 0; m < 4; ++m) _Pragma("unroll") for (int k = 0; k < 2; ++k) dst[m][k] = *(const LAS bf16x8*)(lds + PG8_SA(b, h) + aoff + m * 2048 + k * 1024); } while (0)
#define PG8_LDB(dst, b, h) do { _Pragma("unroll") for (int n = 0; n < 2; ++n) _Pragma("unroll") for (int k = 0; k < 2; ++k) dst[n][k] = *(const LAS bf16x8*)(lds + PG8_SB(b, h) + boff + n * 2048 + k * 1024); } while (0)
#define PG8_MMA(ai, bj, At, Bt) do { __builtin_amdgcn_s_setprio(1); _Pragma("unroll") for (int m = 0; m < 4; ++m) _Pragma("unroll") for (int n = 0; n < 2; ++n) _Pragma("unroll") for (int k = 0; k < 2; ++k) \
        acc[ai][bj][m][n] = __builtin_amdgcn_mfma_f32_16x16x32_bf16(Bt[n][k], At[m][k], acc[ai][bj][m][n], 0, 0, 0); __builtin_amdgcn_s_setprio(0); } while (0)
#define PG8_WAIT_V(n) asm volatile("s_waitcnt vmcnt(" #n ")" ::: "memory")
#define PG8_WAIT_L(n) asm volatile("s_waitcnt lgkmcnt(" #n ")" ::: "memory")
#define PG8_BAR __builtin_amdgcn_s_barrier()
#define PG8_SCHED __builtin_amdgcn_sched_barrier(0)
    Unit cur, nxt; int ui = 0;
    if (!S.next(0, cur)) return;
    f32x4 acc[2][2][4][2];
#pragma unroll
    for (int a = 0; a < 2; ++a)
#pragma unroll
        for (int b = 0; b < 2; ++b)
#pragma unroll
            for (int m = 0; m < 4; ++m)
#pragma unroll
                for (int n = 0; n < 2; ++n) acc[a][b][m][n] = (f32x4){0.f, 0.f, 0.f, 0.f};
    bf16x8 At[4][2], B0[2][2], B1[2][2];
    const char* cA = cur.a; const char* cB = cur.b;
    PG8_STAGE(PG8_SB(0, 0), cB, voffB); PG8_STAGE(PG8_SB(0, 1), cB + hstep, voffB); PG8_STAGE(PG8_SA(0, 0), cA, voffA); PG8_STAGE(PG8_SA(0, 1), cA + hstep, voffA);
    if (wr == 1) PG8_BAR;
    PG8_WAIT_V(2); PG8_BAR;
    PG8_STAGE(PG8_SB(1, 0), cB + kstep, voffB); PG8_STAGE(PG8_SA(1, 0), cA + kstep, voffA); PG8_STAGE(PG8_SB(1, 1), cB + hstep + kstep, voffB);
    PG8_WAIT_V(6); PG8_BAR;
    for (;;) {
        const bool has_next = S.next(ui + 1, nxt);
        const char* nA = has_next ? nxt.a : cA; const char* nB = has_next ? nxt.b : cB;
        const int nt = cur.nt;
        for (int t = 0; t < nt; t += 2) {
            const bool last = (t == nt - 2);
            const char* a1 = cA + (size_t)(t + 1) * kstep;
            const char* a2 = last ? nA : cA + (size_t)(t + 2) * kstep; const char* b2 = last ? nB : cB + (size_t)(t + 2) * kstep;
            const char* a3 = a2 + kstep; const char* b3 = b2 + kstep;
            PG8_LDB(B0, 0, 0); PG8_LDB(B1, 0, 1); PG8_SCHED; PG8_LDA(At, 0, 0); PG8_STAGE(PG8_SA(1, 1), a1 + hstep, voffA);
            PG8_WAIT_V(8); PG8_WAIT_L(0); PG8_BAR; PG8_MMA(0, 0, At, B0); PG8_MMA(0, 1, At, B1); PG8_BAR; PG8_SCHED;
            PG8_LDA(At, 0, 1); PG8_STAGE(PG8_SB(0, 0), b2, voffB); PG8_STAGE(PG8_SB(0, 1), b2 + hstep, voffB); PG8_STAGE(PG8_SA(0, 0), a2, voffA);
            PG8_WAIT_V(8); PG8_WAIT_L(0); PG8_BAR; PG8_MMA(1, 0, At, B0); PG8_MMA(1, 1, At, B1); PG8_BAR; PG8_SCHED;
            PG8_LDB(B0, 1, 0); PG8_LDB(B1, 1, 1); PG8_SCHED; PG8_LDA(At, 1, 0); PG8_STAGE(PG8_SA(0, 1), a2 + hstep, voffA);
            PG8_WAIT_V(8); PG8_WAIT_L(0); PG8_BAR; PG8_MMA(0, 0, At, B0); PG8_MMA(0, 1, At, B1); PG8_BAR; PG8_SCHED;
            PG8_LDA(At, 1, 1); PG8_STAGE(PG8_SB(1, 0), b3, voffB); PG8_STAGE(PG8_SB(1, 1), b3 + hstep, voffB); PG8_STAGE(PG8_SA(1, 0), a3, voffA);
            PG8_WAIT_V(8); PG8_WAIT_L(0); PG8_BAR; PG8_MMA(1, 0, At, B0); PG8_MMA(1, 1, At, B1); PG8_BAR; PG8_SCHED;
        }
        if (wr == 0) PG8_BAR;
        {
            bf16_t* o = S.tab[cur.seg].out; const int ldo = S.tab[cur.seg].ldo, mode = S.tab[cur.seg].mode;
            epilogue(acc, cur.pm, cur.pn, o, S.part, ldo, mode, wr, wc, fr, fq);
        }
        if (!has_next) break;
#pragma unroll
        for (int a = 0; a < 2; ++a)
#pragma unroll
            for (int b = 0; b < 2; ++b)
#pragma unroll
                for (int m = 0; m < 4; ++m)
#pragma unroll
                    for (int n = 0; n < 2; ++n) acc[a][b][m][n] = (f32x4){0.f, 0.f, 0.f, 0.f};
        cur = nxt; cA = nA; cB = nB; ++ui;
        if (wr == 1) PG8_BAR;
    }
    PG8_WAIT_V(0);
    PG8_BAR;
#undef PG8_SA
#undef PG8_SB
#undef PG8_STAGE
#undef PG8_LDA
#undef PG8_LDB
#undef PG8_MMA
#undef PG8_WAIT_V
#undef PG8_WAIT_L
#undef PG8_BAR
#undef PG8_SCHED
}
}

__device__ __forceinline__ int rowmap(int n, int mapmode) {
    if (mapmode == 0) return n;
    if (mapmode == 1) { const int j = n < DFF ? n : n - DFF; return (j >> 7) * 256 + (n < DFF ? 0 : 128) + (j & 127); }
    if (mapmode == 2) { if (n >= 1024) return n; const int j = n & 511; return (j >> 7) * 256 + (n < 512 ? 0 : 128) + (j & 127); }
    if (n < 1024) return 2048 + n; { const int j = (n - 1024) & 1023; return (j >> 7) * 256 + (n < 2048 ? 0 : 128) + (j & 127); }
}
__device__ __forceinline__ void convert_tile(LAS unsigned char* lds, const float* src, bf16_t* dst, int K, int N, int mapmode, int tile) {
    LAS float* T = (LAS float*)lds;
    const int tid = tid_opaque(), ntn = N >> 7, tk = tile / ntn, tn = tile % ntn, k0 = tk * 128, n0 = tn * 128;
    { const int r = tid >> 5, c4 = (tid & 31) * 4; f32x4 v[8];
#pragma unroll
      for (int h = 0; h < 8; ++h) v[h] = *(const f32x4*)(src + (size_t)(k0 + r + 16 * h) * N + n0 + c4);
#pragma unroll
      for (int h = 0; h < 8; ++h) { LAS float* t = T + (r + 16 * h) * 129 + c4; t[0] = v[h][0]; t[1] = v[h][1]; t[2] = v[h][2]; t[3] = v[h][3]; } }
    __syncthreads();
    { const int n = tid >> 2, kc = (tid & 3) * 32; bf16_t* drow = dst + (size_t)rowmap(n0 + n, mapmode) * K + k0 + kc;
#pragma unroll
      for (int q = 0; q < 4; ++q) { float v[8];
#pragma unroll
          for (int j = 0; j < 8; ++j) v[j] = T[(kc + q * 8 + j) * 129 + n];
          u32x4 w; w.x = cvt_pk_bf16(v[0], v[1]); w.y = cvt_pk_bf16(v[2], v[3]); w.z = cvt_pk_bf16(v[4], v[5]); w.w = cvt_pk_bf16(v[6], v[7]);
          *(u32x4*)(drow + q * 8) = w; } }
    __syncthreads();
}
__device__ __forceinline__ void modgemv_task(LAS unsigned char* lds, const float* c, const float* c_ctx, const float* w_mod, const float* b_mod, float* mod, int task) {
    LAS float* sc = (LAS float*)lds;
    LAS float* red = (LAS float*)(lds + 9 * 1024 * 4);
    const int tid = threadIdx.x, wv = tid >> 6, lane = tid & 63, l = task / 72, cgp = task % 72;
    for (int i = tid; i < 9 * 1024; i += NTHREADS) { const int r = i >> 10, k = i & 1023; const float v = r < 8 ? c[r * 1024 + k] : c_ctx[k]; sc[i] = siluf_(v); }
    __syncthreads();
    float acc[9][2];
#pragma unroll
    for (int r = 0; r < 9; ++r) { acc[r][0] = 0.f; acc[r][1] = 0.f; }
    const float* wp = w_mod + (size_t)l * 1024 * NMODW + (size_t)(wv * 128) * NMODW + cgp * 128 + lane * 2;
    for (int k4 = 0; k4 < 32; ++k4) {
        f32x2 w[4];
#pragma unroll
        for (int j = 0; j < 4; ++j) w[j] = *(const f32x2*)(wp + (size_t)(k4 * 4 + j) * NMODW);
#pragma unroll
        for (int r = 0; r < 9; ++r) { const f32x4 s = *(const LAS f32x4*)(sc + r * 1024 + wv * 128 + k4 * 4);
#pragma unroll
            for (int j = 0; j < 4; ++j) { acc[r][0] += s[j] * w[j][0]; acc[r][1] += s[j] * w[j][1]; } }
    }
#pragma unroll
    for (int r = 0; r < 9; ++r) { red[(wv * 18 + r * 2 + 0) * 64 + lane] = acc[r][0]; red[(wv * 18 + r * 2 + 1) * 64 + lane] = acc[r][1]; }
    __syncthreads();
    for (int i = tid; i < 9 * 128; i += NTHREADS) { const int r = i >> 7, cc = i & 127, ln = cc >> 1, e = cc & 1; float s = 0.f;
#pragma unroll
        for (int w8 = 0; w8 < 8; ++w8) s += red[(w8 * 18 + r * 2 + e) * 64 + ln];
        const int n = cgp * 128 + cc; mod[((size_t)l * 9 + r) * NMODW + n] = s + b_mod[l * NMODW + n]; }
    __syncthreads();
}

struct NormP {
    const void* xin_lat; const float* xin_ctx; void* xout;
    int xin_bf, xout_bf;
    const bf16_t* YC;
    const bf16_t* Y; const float* part;
    const float* mod_post; const float* gpost; float coef; int kpost;
    const float* mod_pre; const float* gpre; bf16_t* H; int kpre;
    int nrows, do_post, do_pre;
};
__device__ __forceinline__ void unpack8(const u32x4 w, f32x4& lo, f32x4& hi) { lo = (f32x4){bf_lo(w.x), bf_hi(w.x), bf_lo(w.y), bf_hi(w.y)}; hi = (f32x4){bf_lo(w.z), bf_hi(w.z), bf_lo(w.w), bf_hi(w.w)}; }
__device__ __forceinline__ u32x4 pack8(const f32x4 lo, const f32x4 hi) { u32x4 w; w.x = cvt_pk_bf16(lo[0], lo[1]); w.y = cvt_pk_bf16(lo[2], lo[3]); w.z = cvt_pk_bf16(hi[0], hi[1]); w.w = cvt_pk_bf16(hi[2], hi[3]); return w; }
__device__ __forceinline__ void norm_phase(const NormP& P) {
    const int tid_ = tid_opaque(), lane = tid_ & 63, wv = __builtin_amdgcn_readfirstlane(tid_ >> 6);
    const int ngrp = P.nrows >> 2;
    for (int grp = blockIdx.x * 8 + wv; grp < ngrp; grp += gridDim.x * 8) {
        const int row0 = grp * 4; const bool isctx = row0 >= ML; const int crow = isctx ? 8 : (row0 >> 12);
        f32x4 x[4][2][2];
        if (!isctx && P.xin_bf) { const bf16_t* xb = (const bf16_t*)P.xin_lat + (size_t)row0 * D;
#pragma unroll
            for (int r = 0; r < 4; ++r)
#pragma unroll
                for (int i = 0; i < 2; ++i) { const u32x4 w = *(const u32x4*)(xb + (size_t)r * D + i * 512 + lane * 8); unpack8(w, x[r][i][0], x[r][i][1]); }
        } else { const float* xp = isctx ? P.xin_ctx + (size_t)(row0 - ML) * D : (const float*)P.xin_lat + (size_t)row0 * D;
#pragma unroll
            for (int r = 0; r < 4; ++r)
#pragma unroll
                for (int i = 0; i < 2; ++i) { const float* p = xp + (size_t)r * D + i * 512 + lane * 8; x[r][i][0] = *(const f32x4*)p; x[r][i][1] = *(const f32x4*)(p + 4); } }
        if (P.do_post) {
            u32x4 yw[4][2]; float rstd[4];
            if (isctx && P.YC) {
#pragma unroll
                for (int r = 0; r < 4; ++r) { float ss = 0.f;
#pragma unroll
                    for (int i = 0; i < 2; ++i) { const bf16_t* yp = P.YC + (size_t)(row0 - ML + r) * D + i * 512 + lane * 8; f32x4 a0 = (f32x4){0.f, 0.f, 0.f, 0.f}, a1 = a0;
#pragma unroll
                        for (int j = 0; j < 4; ++j) { f32x4 l, h; unpack8(*(const u32x4*)(yp + (size_t)j * MC * D), l, h); a0 += l; a1 += h; }
                        ss += ((a0[0] * a0[0] + a0[1] * a0[1]) + (a0[2] * a0[2] + a0[3] * a0[3])) + ((a1[0] * a1[0] + a1[1] * a1[1]) + (a1[2] * a1[2] + a1[3] * a1[3])); yw[r][i] = pack8(a0, a1); }
#pragma unroll
                    for (int o = 32; o >= 1; o >>= 1) ss += __shfl_xor(ss, o);
                    rstd[r] = rsqrtf(ss * (1.0f / D) + EPS) * P.coef; }
            } else {
#pragma unroll
                for (int r = 0; r < 4; ++r)
#pragma unroll
                    for (int i = 0; i < 2; ++i) yw[r][i] = *(const u32x4*)(P.Y + (size_t)(row0 + r) * D + i * 512 + lane * 8);
#pragma unroll
                for (int r = 0; r < 4; ++r) { const f32x4* pp = (const f32x4*)(P.part + (size_t)(row0 + r) * 16); const f32x4 p0 = pp[0], p1 = pp[1], p2 = pp[2], p3 = pp[3];
                    const float ssy = ((p0[0] + p0[1]) + (p0[2] + p0[3])) + ((p1[0] + p1[1]) + (p1[2] + p1[3])) + ((p2[0] + p2[1]) + (p2[2] + p2[3])) + ((p3[0] + p3[1]) + (p3[2] + p3[3]));
                    rstd[r] = rsqrtf(ssy * (1.0f / D) + EPS) * P.coef; }
            }
            __builtin_amdgcn_sched_barrier(0);
            const float* gate = P.mod_post + ((size_t)crow * 9 + 3 * P.kpost + 2) * D;
#pragma unroll
            for (int i = 0; i < 2; ++i) { const int col = i * 512 + lane * 8;
                const f32x4 gg0 = *(const f32x4*)(gate + col) * *(const f32x4*)(P.gpost + col), gg1 = *(const f32x4*)(gate + col + 4) * *(const f32x4*)(P.gpost + col + 4);
#pragma unroll
                for (int r = 0; r < 4; ++r) { f32x4 yl, yh; unpack8(yw[r][i], yl, yh); x[r][i][0] += gg0 * (yl * rstd[r]); x[r][i][1] += gg1 * (yh * rstd[r]); } }
            if (!isctx) {
                if (P.xout_bf) {
#pragma unroll
                    for (int r = 0; r < 4; ++r)
#pragma unroll
                        for (int i = 0; i < 2; ++i) *(u32x4*)((bf16_t*)P.xout + (size_t)(row0 + r) * D + i * 512 + lane * 8) = pack8(x[r][i][0], x[r][i][1]);
                } else {
#pragma unroll
                    for (int r = 0; r < 4; ++r)
#pragma unroll
                        for (int i = 0; i < 2; ++i) { float* p = (float*)P.xout + (size_t)(row0 + r) * D + i * 512 + lane * 8; *(f32x4*)p = x[r][i][0]; *(f32x4*)(p + 4) = x[r][i][1]; } } }
        }
        __builtin_amdgcn_sched_barrier(0);
        if (P.do_pre) {
            float rs[4];
#pragma unroll
            for (int r = 0; r < 4; ++r) { float ss = 0.f;
#pragma unroll
                for (int i = 0; i < 2; ++i)
#pragma unroll
                    for (int h = 0; h < 2; ++h) { const f32x4 v = x[r][i][h]; ss += (v[0] * v[0] + v[1] * v[1]) + (v[2] * v[2] + v[3] * v[3]); }
#pragma unroll
                for (int o = 32; o >= 1; o >>= 1) ss += __shfl_xor(ss, o);
                rs[r] = rsqrtf(ss * (1.0f / D) + EPS); }
            const float* sh = P.mod_pre + ((size_t)crow * 9 + 3 * P.kpre) * D; const float* scl = sh + D;
            __builtin_amdgcn_sched_barrier(0);
#pragma unroll
            for (int i = 0; i < 2; ++i) { const int col = i * 512 + lane * 8;
                const f32x4 gs0 = *(const f32x4*)(P.gpre + col) * (1.0f + *(const f32x4*)(scl + col)), gs1 = *(const f32x4*)(P.gpre + col + 4) * (1.0f + *(const f32x4*)(scl + col + 4));
                const f32x4 t0 = *(const f32x4*)(sh + col), t1 = *(const f32x4*)(sh + col + 4);
#pragma unroll
                for (int r = 0; r < 4; ++r) *(u32x4*)(P.H + (size_t)(row0 + r) * D + col) = pack8((x[r][i][0] * rs[r]) * gs0 + t0, (x[r][i][1] * rs[r]) * gs1 + t1); }
        }
    }
}

template <int CTRL> __device__ __forceinline__ float dpp_f(float x) { return __builtin_bit_cast(float, __builtin_amdgcn_mov_dpp(__builtin_bit_cast(int, x), CTRL, 0xf, 0xf, true)); }
__device__ __forceinline__ float half_wave_sum(float v) {
    v += dpp_f<0xB1>(v); v += dpp_f<0x4E>(v); v += dpp_f<0x141>(v); v += dpp_f<0x128>(v);
    v += __builtin_bit_cast(float, __builtin_amdgcn_ds_swizzle(__builtin_bit_cast(int, v), 0x401F));
    return v;
}
template <int I, int K> struct ConvK { static __device__ __forceinline__ void run(f32x2 (&acc)[32], const f32x2 (&w)[31], const f32x2 x) {
    constexpr int o = I - K;
    if constexpr (o >= 0 && o < 32) acc[o] = w[K] * x + acc[o];
    if constexpr (K + 1 < 31) ConvK<I, K + 1>::run(acc, w, x); } };
template <int I> struct ConvI { static __device__ __forceinline__ void run(f32x2 (&acc)[32], const f32x2 (&w)[31], const LAS unsigned char* p) {
    const unsigned xv = *(const LAS unsigned*)(p + I * 1024); const f32x2 x = (f32x2){bf_lo(xv), bf_hi(xv)};
    ConvK<I, 0>::run(acc, w, x);
    if constexpr (I + 1 < 62) ConvI<I + 1>::run(acc, w, p); } };
template <int O> struct ConvOut { static __device__ __forceinline__ void run(const f32x2 (&acc)[32], const f32x2 lg, const f32x2 lb, bf16_t* yp) {
    const f32x2 a = acc[O];
    const float s = half_wave_sum(a[0] + a[1]), q = half_wave_sum(a[0] * a[0] + a[1] * a[1]);
    const float mu = s * (1.0f / 64.0f); float var = q * (1.0f / 64.0f) - mu * mu; var = var < 0.f ? 0.f : var; const float rstd = rsqrtf(var + EPS);
    const float v0 = (a[0] - mu) * rstd * lg[0] + lb[0], v1 = (a[1] - mu) * rstd * lg[1] + lb[1];
    *(unsigned*)(yp + (size_t)O * D) = cvt_pk_bf16(siluf_(v0), siluf_(v1));
    if constexpr (O + 1 < 32) ConvOut<O + 1>::run(acc, lg, lb, yp); } };
__device__ __forceinline__ void conv_tile(LAS unsigned char* lds, const bf16_t* UA, const float* dw_w, const float* dw_b, const float* ln_g, const float* ln_b, bf16_t* YAB, int tile) {
    const int tid = tid_opaque(), b = tile >> 6, t0 = (tile & 63) * 64;
    {   u32x4 v[12];
#pragma unroll
        for (int j = 0; j < 12; ++j) { const int idx = tid + j * NTHREADS, rr = idx >> 6, c16 = idx & 63, t = t0 - 15 + rr; v[j] = (u32x4){0u, 0u, 0u, 0u};
            if (rr < 94 && t >= 0 && t < SEQ) v[j] = *(const u32x4*)(UA + (size_t)(b * SEQ + t) * LDU + c16 * 8); }
#pragma unroll
        for (int j = 0; j < 12; ++j) { const int idx = tid + j * NTHREADS, rr = idx >> 6, c16 = idx & 63; if (rr < 94) *(LAS u32x4*)(lds + rr * 1024 + c16 * 16) = v[j]; } }
    __syncthreads();
    const int cp = tid & 255, th = tid >> 8;
    f32x2 w[31];
#pragma unroll
    for (int k = 0; k < 31; ++k) w[k] = *(const f32x2*)(dw_w + k * 512 + 2 * cp);
    const f32x2 bias = *(const f32x2*)(dw_b + 2 * cp);
    f32x2 acc[32];
#pragma unroll
    for (int o = 0; o < 32; ++o) acc[o] = bias;
    ConvI<0>::run(acc, w, lds + th * 32 * 1024 + cp * 4);
    const f32x2 lg = *(const f32x2*)(ln_g + 2 * cp), lb = *(const f32x2*)(ln_b + 2 * cp);
    ConvOut<0>::run(acc, lg, lb, YAB + (size_t)(b * SEQ + t0 + th * 32) * D + 2 * cp);
    __syncthreads();
}

#define MFMA16(a, b, c) __builtin_amdgcn_mfma_f32_16x16x32_bf16((a), (b), (c), 0, 0, 0)
constexpr int RING_V = 9 * 8192, ATT_LB = 2 * 9 * 8192;
constexpr float SC2 = 0.125f * 1.44269504f;
__device__ __forceinline__ void ring_load(LAS unsigned char* lds, const bf16_t* kbase, const bf16_t* vbase, int Rlo, int Rhi) {
    const int tid = threadIdx.x, n = (Rhi - Rlo + 1) * 512;
    for (int i0 = 0; i0 < n; i0 += 4 * NTHREADS) {
        u32x4 kk[4], vv[4];
#pragma unroll
        for (int j = 0; j < 4; ++j) { const int i = i0 + j * NTHREADS + tid; if (i < n) { const int R = Rlo + (i >> 9), c = i & 511;
            kk[j] = *(const u32x4*)(kbase + (size_t)R * 4096 + c * 8); vv[j] = *(const u32x4*)(vbase + (size_t)R * 4096 + c * 8); } }
#pragma unroll
        for (int j = 0; j < 4; ++j) { const int i = i0 + j * NTHREADS + tid; if (i < n) { const int R = Rlo + (i >> 9), c = i & 511, sl = R % 9;
            *(LAS u32x4*)(lds + sl * 8192 + c * 16) = kk[j]; *(LAS u32x4*)(lds + RING_V + sl * 8192 + c * 16) = vv[j]; } }
    }
}
__device__ __forceinline__ int clampi(int v, int lo, int hi) { return v < lo ? lo : (v > hi ? hi : v); }
__device__ __forceinline__ void attn_block(LAS unsigned char* lds, const bf16_t* UA, const bf16_t* KT, const bf16_t* KC, const bf16_t* VT, const bf16_t* VC, const float* rpb,
                                           u32x2* O2, f32x2* MS2, bf16_t* YAB, int blk) {
    const int tid = tid_opaque(), wv = tid >> 6, lane = tid & 63, fr = lane & 15, quad = lane >> 4;
    const int rq = blk & 3, h = (blk >> 2) & 7, b = blk >> 5, r0 = rq * 16;
    const f32x4 z4 = (f32x4){0.f, 0.f, 0.f, 0.f};
    const int ct = wv & 3, c0 = ct * 16, cb = clampi(c0 - 8, 0, 32), c = c0 + fr, cs = clampi(c - 8, 0, 48);
    const bf16_t* qbase = UA + ((size_t)b * SEQ + c) * LDU + 512 + h * 64 + quad * 8;
    u32x2* o2p = O2 + ((size_t)blk * 64 * 4) * 64 + lane; f32x2* msp = MS2 + (size_t)blk * 64 * 64 + lane;
    {
        LAS unsigned char* Lk = lds; LAS unsigned char* Lv = lds + 32768;
        const u32x4* gk = (const u32x4*)(KC + (size_t)(b * 8 + h) * 16 * 2 * 64 * 8); const u32x4* gv = (const u32x4*)(VC + (size_t)(b * 8 + h) * 16 * 4 * 64 * 4);
        u32x4 tk[4], tv[4];
#pragma unroll
        for (int j = 0; j < 4; ++j) { tk[j] = gk[tid + j * NTHREADS]; tv[j] = gv[tid + j * NTHREADS]; }
#pragma unroll
        for (int j = 0; j < 4; ++j) { ((LAS u32x4*)Lk)[tid + j * NTHREADS] = tk[j];
            const int u = (tid + j * NTHREADS) * 2, ln = u & 63, dt = (u >> 6) & 3, t = u >> 8;
            LAS unsigned char* d = Lv + ((((t >> 1) * 4 + dt) * 64 + ln) * 16) + (t & 1) * 8;
            *(LAS u32x2*)d = (u32x2){tv[j].x, tv[j].y}; *(LAS u32x2*)(d + 16) = (u32x2){tv[j].z, tv[j].w}; }
        __syncthreads();
        bf16x8 q0 = *(const bf16x8*)(qbase + (size_t)(r0 + (wv >> 2)) * 64 * LDU), q1 = *(const bf16x8*)(qbase + (size_t)(r0 + (wv >> 2)) * 64 * LDU + 32);
        for (int p = 0; p < 8; ++p) {
            const int it = p * 8 + wv, rn = r0 + (p < 7 ? 2 * p + 2 : 0) + (wv >> 2);
            const bf16x8 qn0 = *(const bf16x8*)(qbase + (size_t)rn * 64 * LDU), qn1 = *(const bf16x8*)(qbase + (size_t)rn * 64 * LDU + 32);
            f32x4 o2[4] = {z4, z4, z4, z4}; float m2 = -1e30f, s2 = 0.f;
            f32x4 sx[16];
#pragma unroll
            for (int t = 0; t < 16; ++t) { const bf16x8 k0 = *(const LAS bf16x8*)(Lk + ((t * 2 + 0) * 64 + lane) * 16), k1 = *(const LAS bf16x8*)(Lk + ((t * 2 + 1) * 64 + lane) * 16);
                sx[t] = MFMA16(k1, q1, MFMA16(k0, q0, z4)); }
            {   f32x4 vm = sx[0];
#pragma unroll
                for (int t = 1; t < 16; ++t) vm = __builtin_elementwise_max(vm, sx[t]);
                m2 = fmaxf(fmaxf(vm[0], vm[1]), fmaxf(vm[2], vm[3])); m2 = fmaxf(m2, __shfl_xor(m2, 16)); m2 = fmaxf(m2, __shfl_xor(m2, 32));
                m2 *= SC2;
                f32x4 vs = z4;
#pragma unroll
                for (int t = 0; t < 16; ++t) { f32x4 e = sx[t] * SC2 - m2; e[0] = __builtin_amdgcn_exp2f(e[0]); e[1] = __builtin_amdgcn_exp2f(e[1]); e[2] = __builtin_amdgcn_exp2f(e[2]); e[3] = __builtin_amdgcn_exp2f(e[3]); sx[t] = e; vs += e; }
                s2 = (vs[0] + vs[1]) + (vs[2] + vs[3]); s2 += __shfl_xor(s2, 16); s2 += __shfl_xor(s2, 32); }
#pragma unroll
            for (int kb = 0; kb < 8; ++kb) {
                u32x4 pw; pw.x = cvt_pk_bf16(sx[2 * kb][0], sx[2 * kb][1]); pw.y = cvt_pk_bf16(sx[2 * kb][2], sx[2 * kb][3]); pw.z = cvt_pk_bf16(sx[2 * kb + 1][0], sx[2 * kb + 1][1]); pw.w = cvt_pk_bf16(sx[2 * kb + 1][2], sx[2 * kb + 1][3]);
                const bf16x8 pf = __builtin_bit_cast(bf16x8, pw);
#pragma unroll
                for (int dt = 0; dt < 4; ++dt) o2[dt] = MFMA16(*(const LAS bf16x8*)(Lv + ((kb * 4 + dt) * 64 + lane) * 16), pf, o2[dt]);
            }
            const float i2 = 1.0f / s2;
#pragma unroll
            for (int dt = 0; dt < 4; ++dt) { u32x2 w; w.x = cvt_pk_bf16(o2[dt][0] * i2, o2[dt][1] * i2); w.y = cvt_pk_bf16(o2[dt][2] * i2, o2[dt][3] * i2); o2p[(size_t)(it * 4 + dt) * 64] = w; }
            msp[(size_t)it * 64] = (f32x2){m2, s2};
            q0 = qn0; q1 = qn1;
        }
    }
    __syncthreads();
    {
        LAS float* Lb = (LAS float*)(lds + ATT_LB);
        if (tid < 465) Lb[tid] = rpb[h * 465 + tid] * 1.44269504f;
        const bf16_t* kbase = KT + (size_t)(b * 8 + h) * 256 * 2 * 64 * 8;
        const bf16_t* vbase = VT + (size_t)(b * 8 + h) * 256 * 4 * 64 * 4;
        bf16x8 q0 = *(const bf16x8*)(qbase + (size_t)(r0 + (wv >> 2)) * 64 * LDU), q1 = *(const bf16x8*)(qbase + (size_t)(r0 + (wv >> 2)) * 64 * LDU + 32);
        int cjo[2][4]; f32x4 madd[2];
#pragma unroll
        for (int T = 0; T < 2; ++T)
#pragma unroll
            for (int j = 0; j < 4; ++j) { const int kc = cb + T * 16 + quad * 4 + j; cjo[T][j] = clampi(kc - c + 15, 0, 30); madd[T][j] = ((unsigned)(kc - cs) < 16u) ? 0.f : -1e30f; }
        int prev_hi = clampi(r0 + 1 - 4, 0, 56) + 7;
        ring_load(lds, kbase, vbase, clampi(r0 - 4, 0, 56), prev_hi);
        __syncthreads();
        for (int p = 0; p < 8; ++p) {
            const int nhi = p < 7 ? clampi(r0 + 2 * p + 3 - 4, 0, 56) + 7 : prev_hi, nnew = nhi - prev_hi;
            u32x4 pk[2], pv[2];
#pragma unroll
            for (int j = 0; j < 2; ++j) if (j < nnew) { const size_t go = (size_t)(prev_hi + 1 + j) * 4096 + tid * 8; pk[j] = *(const u32x4*)(kbase + go); pv[j] = *(const u32x4*)(vbase + go); }
            const int it = p * 8 + wv, r = r0 + 2 * p + (wv >> 2), rs = clampi(r - 4, 0, 56), rn = r0 + (p < 7 ? 2 * p + 2 : 0) + (wv >> 2);
            const bf16x8 qn0 = *(const bf16x8*)(qbase + (size_t)rn * 64 * LDU), qn1 = *(const bf16x8*)(qbase + (size_t)rn * 64 * LDU + 32);
            u32x2 o2w[4];
#pragma unroll
            for (int dt = 0; dt < 4; ++dt) o2w[dt] = o2p[(size_t)(it * 4 + dt) * 64];
            const f32x2 ms = msp[(size_t)it * 64];
            f32x4 o1[4] = {z4, z4, z4, z4}; float m1 = -1e30f, s1 = 0.f;
            f32x4 sw[8][2];
#pragma unroll
            for (int i = 0; i < 8; ++i) { const LAS unsigned char* Ks = lds + ((rs + i) % 9) * 8192;
#pragma unroll
                for (int T = 0; T < 2; ++T) { const int col = cb + T * 16 + fr; const LAS unsigned char* kp = Ks + (((col >> 4) * 2) * 64 + quad * 16 + (col & 15)) * 16;
                    const bf16x8 k0 = *(const LAS bf16x8*)kp, k1 = *(const LAS bf16x8*)(kp + 1024);
                    sw[i][T] = MFMA16(k1, q1, MFMA16(k0, q0, z4)); } }
            {   f32x4 vm = (f32x4){-1e30f, -1e30f, -1e30f, -1e30f};
#pragma unroll
                for (int i = 0; i < 8; ++i) { const LAS float* rrow = Lb + (rs + i - r + 7) * 31;
#pragma unroll
                    for (int T = 0; T < 2; ++T) { const f32x4 bv = (f32x4){rrow[cjo[T][0]], rrow[cjo[T][1]], rrow[cjo[T][2]], rrow[cjo[T][3]]};
                        const f32x4 l = sw[i][T] * SC2 + (bv + madd[T]); sw[i][T] = l; vm = __builtin_elementwise_max(vm, l); } }
                m1 = fmaxf(fmaxf(vm[0], vm[1]), fmaxf(vm[2], vm[3])); m1 = fmaxf(m1, __shfl_xor(m1, 16)); m1 = fmaxf(m1, __shfl_xor(m1, 32));
                f32x4 vs = z4;
#pragma unroll
                for (int i = 0; i < 8; ++i)
#pragma unroll
                    for (int T = 0; T < 2; ++T) { f32x4 e = sw[i][T] - m1; e[0] = __builtin_amdgcn_exp2f(e[0]); e[1] = __builtin_amdgcn_exp2f(e[1]); e[2] = __builtin_amdgcn_exp2f(e[2]); e[3] = __builtin_amdgcn_exp2f(e[3]); sw[i][T] = e; vs += e; }
                s1 = (vs[0] + vs[1]) + (vs[2] + vs[3]); s1 += __shfl_xor(s1, 16); s1 += __shfl_xor(s1, 32); }
            const int colv = cb + quad * 4;
#pragma unroll
            for (int i = 0; i < 8; ++i) {
                u32x4 pw; pw.x = cvt_pk_bf16(sw[i][0][0], sw[i][0][1]); pw.y = cvt_pk_bf16(sw[i][0][2], sw[i][0][3]); pw.z = cvt_pk_bf16(sw[i][1][0], sw[i][1][1]); pw.w = cvt_pk_bf16(sw[i][1][2], sw[i][1][3]);
                const bf16x8 pf = __builtin_bit_cast(bf16x8, pw);
                const LAS unsigned char* vp = lds + RING_V + ((rs + i) % 9) * 8192 + (((colv >> 4) * 4) * 64 + ((colv & 15) >> 2) * 16 + fr) * 8;
#pragma unroll
                for (int dt = 0; dt < 4; ++dt) { const s16x4 lo = *(const LAS s16x4*)(vp + dt * 512), hi = *(const LAS s16x4*)(vp + dt * 512 + 2048);
                    o1[dt] = MFMA16(__builtin_shufflevector(lo, hi, 0, 1, 2, 3, 4, 5, 6, 7), pf, o1[dt]); }
            }
            const float m2 = ms[0], s2 = ms[1], mm = fmaxf(m1, m2), a1 = __builtin_amdgcn_exp2f(m1 - mm), a2 = __builtin_amdgcn_exp2f(m2 - mm) * s2, inv = 1.0f / (s1 * a1 + a2), f1 = a1 * inv, f2 = a2 * inv;
            bf16_t* op = YAB + ((size_t)b * SEQ + r * 64 + c) * D + 512 + h * 64 + quad * 4;
#pragma unroll
            for (int dt = 0; dt < 4; ++dt) { u32x2 w; w.x = cvt_pk_bf16(o1[dt][0] * f1 + bf_lo(o2w[dt].x) * f2, o1[dt][1] * f1 + bf_hi(o2w[dt].x) * f2);
                w.y = cvt_pk_bf16(o1[dt][2] * f1 + bf_lo(o2w[dt].y) * f2, o1[dt][3] * f1 + bf_hi(o2w[dt].y) * f2);
                *(u32x2*)(op + dt * 16) = w; }
            q0 = qn0; q1 = qn1;
            __syncthreads();
#pragma unroll
            for (int j = 0; j < 2; ++j) if (j < nnew) { const int sl = (prev_hi + 1 + j) % 9; *(LAS u32x4*)(lds + sl * 8192 + tid * 16) = pk[j]; *(LAS u32x4*)(lds + RING_V + sl * 8192 + tid * 16) = pv[j]; }
            prev_hi = nhi;
            __syncthreads();
        }
    }
}

__device__ __forceinline__ void conv3_phase(const bf16_t* CX, const bf16_t* BG, const float* cw, bf16_t* S) {
    constexpr int RUN = 8;
    for (int task = blockIdx.x * NTHREADS + threadIdx.x; task < (ML / RUN) * 128; task += gridDim.x * NTHREADS) {
        const int c8 = (task & 127) * 8, tok0 = (task >> 7) * RUN, t0 = tok0 & (SEQ - 1);
        f32x4 w[3][2];
#pragma unroll
        for (int k = 0; k < 3; ++k) { w[k][0] = *(const f32x4*)(cw + k * D + c8); w[k][1] = *(const f32x4*)(cw + k * D + c8 + 4); }
        const u32x4 z = (u32x4){0u, 0u, 0u, 0u};
        u32x4 rows[RUN + 2], bg[RUN];
        rows[0] = t0 > 0 ? *(const u32x4*)(CX + (size_t)(tok0 - 1) * D + c8) : z;
#pragma unroll
        for (int j = 0; j < RUN; ++j) { rows[j + 1] = *(const u32x4*)(CX + (size_t)(tok0 + j) * D + c8); bg[j] = *(const u32x4*)(BG + (size_t)(tok0 + j) * D + c8); }
        rows[RUN + 1] = (t0 + RUN < SEQ) ? *(const u32x4*)(CX + (size_t)(tok0 + RUN) * D + c8) : z;
#pragma unroll
        for (int j = 0; j < RUN; ++j) { f32x4 pl, ph, cl, ch, nl, nh, bl, bh;
            unpack8(rows[j], pl, ph); unpack8(rows[j + 1], cl, ch); unpack8(rows[j + 2], nl, nh); unpack8(bg[j], bl, bh);
            const f32x4 rl = bl * (w[0][0] * pl + w[1][0] * cl + w[2][0] * nl), rh = bh * (w[0][1] * ph + w[1][1] * ch + w[2][1] * nh);
            *(u32x4*)(S + (size_t)(tok0 + j) * D + c8) = pack8(rl, rh); }
    }
}

#define XB_TMO      128
#define XB_XCNT(j)  (256  + 64 * (j))
#define XB_XSUB(j)  (1280 + 64 * (j))
#define XB_XGEN(j)  (2304 + 64 * (j))
#define XB_TOP      3328
#define XB_TOPGEN   3392
#define XCD_BAR_WORDS 3456
#define XB_SPIN_CAP (1u << 20)
__device__ __forceinline__ unsigned xb_ld(unsigned* p)              { return __hip_atomic_load(p, __ATOMIC_RELAXED, __HIP_MEMORY_SCOPE_AGENT); }
__device__ __forceinline__ unsigned xb_add(unsigned* p, unsigned v) { return __hip_atomic_fetch_add(p, v, __ATOMIC_RELAXED, __HIP_MEMORY_SCOPE_AGENT); }
__device__ __forceinline__ unsigned xb_xcc_id() { return (unsigned)__builtin_amdgcn_s_getreg((3 << 11) | 20) & 0xFu; }
#define XB_SPIN(cond, bar) do { unsigned _sp = 0; while (cond) { __builtin_amdgcn_s_sleep(1); \
    if ((++_sp & 255u) == 0u) { if (xb_ld(&(bar)[XB_TMO])) break; if (_sp > XB_SPIN_CAP) { atomicAdd(&(bar)[XB_TMO], 1u); break; } } } } while (0)
struct XcdBarrier { unsigned* bar; unsigned x; volatile LAS unsigned* st; };
__device__ __forceinline__ XcdBarrier xcd_barrier_post(unsigned* bar, volatile LAS unsigned* st) {
    XcdBarrier b; b.bar = bar; b.x = xb_xcc_id(); b.st = st;
    if (threadIdx.x == 0) (void)xb_add(&bar[XB_XCNT(b.x)], 1u);
    return b;
}
__device__ __forceinline__ void xcd_barrier_complete(unsigned* bar, unsigned x, unsigned& nloc, unsigned& nx) {
    const unsigned G = gridDim.x * gridDim.y * gridDim.z;
    unsigned sum, cnt, mine, sp = 0u;
    for (;;) {
        sum = 0u; cnt = 0u; mine = 0u;
#pragma unroll
        for (unsigned j = 0; j < 16; ++j) { const unsigned c = xb_ld(&bar[XB_XCNT(j)]); sum += c; cnt += (c > 0u) ? 1u : 0u; mine = (j == x) ? c : mine; }
        if (sum == G) break;
        __builtin_amdgcn_s_sleep(1);
        if ((++sp & 255u) == 0u) { if (xb_ld(&bar[XB_TMO])) break; if (sp > XB_SPIN_CAP) { atomicAdd(&bar[XB_TMO], 1u); break; } }
    }
    nloc = mine > 0u ? mine : 1u; nx = cnt > 0u ? cnt : 1u;
}
__device__ __forceinline__ void xcd_barrier(const XcdBarrier& b) {
    asm volatile("s_waitcnt vmcnt(0)" ::: "memory");
    __syncthreads();
    if (threadIdx.x == 0) {
        unsigned* bar = b.bar;
        __builtin_amdgcn_s_waitcnt(0);
        unsigned nloc = b.st[0], nx = b.st[1];
        if (nloc == 0u) { xcd_barrier_complete(bar, b.x, nloc, nx); b.st[0] = nloc; b.st[1] = nx; }
        const unsigned old = xb_add(&bar[XB_XSUB(b.x)], 1u);
        const unsigned gen = old / nloc;
        if (old + 1u == (gen + 1u) * nloc) {
            __builtin_amdgcn_fence(__ATOMIC_RELEASE, "agent");
            asm volatile("s_waitcnt vmcnt(0)" ::: "memory");
            const unsigned og = xb_add(&bar[XB_TOP], 1u);
            const unsigned tg = og / nx;
            if (og + 1u == (tg + 1u) * nx) xb_add(&bar[XB_TOPGEN], 1u);
            else XB_SPIN(xb_ld(&bar[XB_TOPGEN]) == tg, bar);
            __builtin_amdgcn_fence(__ATOMIC_ACQUIRE, "agent");
            xb_add(&bar[XB_XGEN(b.x)], 1u);
            asm volatile("s_waitcnt vmcnt(0)" ::: "memory");
        } else {
            XB_SPIN(xb_ld(&bar[XB_XGEN(b.x)]) == gen, bar);
            __builtin_amdgcn_fence(__ATOMIC_ACQUIRE, "agent");
            asm volatile("s_waitcnt vmcnt(0)" ::: "memory");
        }
    }
    __syncthreads();
}

struct Args { const float* in[21]; float* out; unsigned char* ws; int ph_lo, ph_hi; };
constexpr int LDS_BYTES = 150 * 1024;

__device__ __forceinline__ pg8::Sched sched_init(LAS unsigned char* lds, int K, float* part) {
    pg8::Sched S; S.tab = (LAS pg8::SegD*)(lds + pg8::STAGE_BYTES); S.part = part; S.ns = 0; S.total = 0; S.G = gridDim.x; S.c = blockIdx.x; S.K = K; S.split_seg = 0; S.total0 = 0; return S;
}
__device__ __forceinline__ void ffn_gu(LAS unsigned char* lds, unsigned char* ws, int wi, int nM) {
    pg8::Sched S = sched_init(lds, D, nullptr);
    pg8::seg_set(S, 0, (const char*)(ws + WS_H), (const char*)(ws + WS_WGU + (size_t)wi * SZ_WGU), (bf16_t*)(ws + WS_ACT), nM, 22, DFF, pg8::M_SILU);
    __syncthreads();
    pg8::gemm_phase(lds, S);
}
__device__ __forceinline__ void gemm_y(LAS unsigned char* lds, unsigned char* ws, const char* A, const char* Bt, int K, int nM) {
    pg8::Sched S = sched_init(lds, K, (float*)(ws + WS_PART));
    pg8::seg_set(S, 0, A, Bt, (bf16_t*)(ws + WS_Y), nM, 4, D, pg8::M_Y);
    __syncthreads();
    pg8::gemm_phase(lds, S);
}

__global__ void __launch_bounds__(NTHREADS, 2) fwd_kernel(Args args) {
    extern __shared__ __attribute__((aligned(16))) unsigned char lds_raw[];
    LAS unsigned char* lds = (LAS unsigned char*)lds_raw;
    cg::grid_group grid = cg::this_grid();
    unsigned char* ws = args.ws;
    const int lo = args.ph_lo, hi = args.ph_hi;
#define IN(k) (lo <= (k) && (k) < hi)
#define REP(k) for (int _r = 0; _r < ((k) == DUP_PHASE ? 2 : 1); ++_r)
#define SEAM(k) do { if (IN(k) && IN((k) + 1)) xcd_barrier(xbar); } while (0)
    const float* x_in = args.in[0]; const float* ctx_in = args.in[2];
    const float* norm_g = args.in[6];
    float* mod = (float*)(ws + WS_MOD);
    bf16_t* xres = (bf16_t*)(ws + WS_XB);
    bf16_t* yab = (bf16_t*)args.out;
    const int G = gridDim.x, bid = blockIdx.x;
    volatile LAS unsigned* xst = (volatile LAS unsigned*)(lds + LDS_BYTES - 16);
    if (threadIdx.x == 0) { xst[0] = 0u; xst[1] = 0u; }
    __syncthreads();
    XcdBarrier xbar; xbar.bar = (unsigned*)(ws + WS_CTL); xbar.x = 0; xbar.st = xst;
    if (hi - lo > 1) xbar = xcd_barrier_post((unsigned*)(ws + WS_CTL), xst);

    if (IN(0)) REP(0) {
        for (int task = bid; task < 144; task += G) modgemv_task(lds, args.in[1], args.in[3], args.in[4], args.in[5], mod, task);
        {
            constexpr int NMAT = 12;
            int tstart[NMAT + 1]; { int t = 0;
#pragma unroll
                for (int mi = 0; mi < NMAT; ++mi) { tstart[mi] = t; const int K = (mi >= 4 && mi < 8) ? DFF : D, N = mi < 4 ? 2 * DFF : (mi < 8 ? D : (mi == 8 ? 2560 : (mi == 10 ? 3072 : D))); t += (K >> 7) * (N >> 7); } tstart[NMAT] = t; }
            const int nfree = G > 144 ? G - 144 : 0, NB = 2 * nfree;
            for (int pass = 0; pass < 2; ++pass) {
            const int t_lo = pass == 0 ? (bid >= 144 ? bid - 144 : NB) : NB + (G - 1 - bid), t_hi = pass == 0 ? NB : tstart[NMAT], t_st = pass == 0 ? (nfree > 0 ? nfree : 1) : G;
            for (int tt = t_lo; tt < t_hi; tt += t_st) {
                int mi = 0, t0 = 0;
#pragma unroll
                for (int k = 1; k < NMAT; ++k) if (tt >= tstart[k]) { mi = k; t0 = tstart[k]; }
                const float* src; bf16_t* dst; int K, N, mm;
                if (mi < 4) { const int l = mi >> 1, f = mi & 1; src = args.in[f ? 9 : 7] + (size_t)l * D * 2 * DFF; dst = (bf16_t*)(ws + WS_WGU + (size_t)mi * SZ_WGU); K = D; N = 2 * DFF; mm = 1; }
                else if (mi < 8) { const int l = (mi - 4) >> 1, f = (mi - 4) & 1; src = args.in[f ? 10 : 8] + (size_t)l * DFF * D; dst = (bf16_t*)(ws + WS_WDN + (size_t)(mi - 4) * SZ_WDN); K = DFF; N = D; mm = 0; }
                else if (mi == 8) { src = args.in[11]; dst = (bf16_t*)(ws + WS_WEVIN); K = D; N = 2560; mm = 2; }
                else if (mi == 9) { src = args.in[12]; dst = (bf16_t*)(ws + WS_WEVOUT); K = D; N = D; mm = 0; }
                else if (mi == 10) { src = args.in[18]; dst = (bf16_t*)(ws + WS_WODIN); K = D; N = 3072; mm = 3; }
                else { src = args.in[20]; dst = (bf16_t*)(ws + WS_WODOUT); K = D; N = D; mm = 0; }
                convert_tile(lds, src, dst, K, N, mm, tt - t0);
            }
            }
        }
    }
    SEAM(0);
    if (IN(1)) REP(1) { NormP P{}; P.xin_lat = x_in; P.xin_ctx = ctx_in; P.do_post = 0; P.do_pre = 1; P.mod_pre = mod; P.kpre = 0; P.gpre = norm_g + 0 * D; P.H = (bf16_t*)(ws + WS_H); P.nrows = MT; norm_phase(P); }
    SEAM(1);
    if (IN(2)) REP(2) ffn_gu(lds, ws, 0, MT / 256);
    SEAM(2);
    if (IN(3)) REP(3) {
        pg8::Sched S = sched_init(lds, DFF, (float*)(ws + WS_PART));
        const char* A = (const char*)(ws + WS_ACT); const char* B = (const char*)(ws + WS_WDN);
        pg8::seg_set(S, 0, A, B, (bf16_t*)(ws + WS_Y), ML / 256, 4, D, pg8::M_Y);
        if ((ML / 256 * 4) % G == 0) { S.split_seg = 1; S.total0 = S.total; }
        const int ks[4] = {0, 768, 1536, 2176}, kt[4] = {12, 12, 10, 10};
#pragma unroll
        for (int j = 0; j < 4; ++j) pg8::seg_set(S, 1 + j, A + (size_t)ML * DFF * 2 + ks[j] * 2, B + ks[j] * 2, (bf16_t*)args.out + (size_t)j * MC * D, MC / 256, 4, D, pg8::M_PLAIN, kt[j]);
        __syncthreads();
        pg8::gemm_phase(lds, S);
    }
    SEAM(3);
    if (IN(4)) REP(4) { NormP P{}; P.xin_lat = x_in; P.xin_ctx = ctx_in; P.xout = xres; P.xin_bf = 0; P.xout_bf = 1; P.YC = (const bf16_t*)args.out; P.Y = (const bf16_t*)(ws + WS_Y); P.part = (const float*)(ws + WS_PART);
        P.do_post = 1; P.mod_post = mod; P.kpost = 0; P.gpost = norm_g + 1 * D; P.coef = 0.5f;
        P.do_pre = 1; P.mod_pre = mod; P.kpre = 1; P.gpre = norm_g + 2 * D; P.H = (bf16_t*)(ws + WS_H); P.nrows = MT; norm_phase(P); }
    SEAM(4);
    if (IN(5)) REP(5) {
        pg8::Sched S = sched_init(lds, D, (float*)(ws + WS_VC)); const char* Hb = (const char*)(ws + WS_H); const char* W = (const char*)(ws + WS_WEVIN);
        pg8::seg_set(S, 0, Hb, W, (bf16_t*)(ws + WS_UA), 128, 4, LDU, pg8::M_GLU);
        pg8::seg_set(S, 1, Hb, W + (size_t)1024 * D * 2, (bf16_t*)(ws + WS_UA) + 512, 128, 2, LDU, pg8::M_PLAIN);
        pg8::seg_set(S, 2, Hb, W + (size_t)1536 * D * 2, (bf16_t*)(ws + WS_KT), 128, 2, 12, pg8::M_KT);
        pg8::seg_set(S, 3, Hb + (size_t)ML * D * 2, W + (size_t)1536 * D * 2, (bf16_t*)(ws + WS_KC), 8, 2, 8, pg8::M_KT);
        pg8::seg_set(S, 4, W + (size_t)2048 * D * 2, Hb, (bf16_t*)(ws + WS_VT), 2, MT / 256, 0, pg8::M_VT);
        __syncthreads();
        pg8::gemm_phase(lds, S);
    }
    SEAM(5);
    if (IN(6)) {
        for (int t = bid; t < 512 * (DUP_PHASE == 6 ? 2 : 1); t += G) conv_tile(lds, (const bf16_t*)(ws + WS_UA), args.in[13], args.in[14], args.in[15], args.in[16], yab, t & 511);
        for (int blk = bid; blk < 256 * (DUP_PHASE == 66 ? 2 : 1); blk += G)
            attn_block(lds, (const bf16_t*)(ws + WS_UA), (const bf16_t*)(ws + WS_KT), (const bf16_t*)(ws + WS_KC), (const bf16_t*)(ws + WS_VT), (const bf16_t*)(ws + WS_VC), args.in[17], (u32x2*)(ws + WS_H), (f32x2*)(ws + WS_Y), yab, blk & 255);
    }
    SEAM(6);
    if (IN(7)) REP(7) gemm_y(lds, ws, (const char*)yab, (const char*)(ws + WS_WEVOUT), D, ML / 256);
    SEAM(7);
    if (IN(8)) REP(8) { NormP P{}; P.xin_lat = xres; P.xin_ctx = ctx_in; P.xout = xres; P.xin_bf = 1; P.xout_bf = 1; P.Y = (const bf16_t*)(ws + WS_Y); P.part = (const float*)(ws + WS_PART);
        P.do_post = 1; P.mod_post = mod; P.kpost = 1; P.gpost = norm_g + 3 * D; P.coef = 1.0f;
        P.do_pre = 1; P.mod_pre = mod; P.kpre = 2; P.gpre = norm_g + 4 * D; P.H = (bf16_t*)(ws + WS_H); P.nrows = ML; norm_phase(P); }
    SEAM(8);
    if (IN(9)) REP(9) ffn_gu(lds, ws, 1, ML / 256);
    SEAM(9);
    if (IN(10)) REP(10) gemm_y(lds, ws, (const char*)(ws + WS_ACT), (const char*)(ws + WS_WDN + 1 * SZ_WDN), DFF, ML / 256);
    SEAM(10);
    const float* mod1 = mod + (size_t)9 * NMODW; const float* ng1 = norm_g + 6 * D;
    if (IN(11)) REP(11) { NormP P{}; P.xin_lat = xres; P.xin_ctx = ctx_in; P.xout = xres; P.xin_bf = 1; P.xout_bf = 1; P.Y = (const bf16_t*)(ws + WS_Y); P.part = (const float*)(ws + WS_PART);
        P.do_post = 1; P.mod_post = mod; P.kpost = 2; P.gpost = norm_g + 5 * D; P.coef = 0.5f;
        P.do_pre = 1; P.mod_pre = mod1; P.kpre = 0; P.gpre = ng1 + 0 * D; P.H = (bf16_t*)(ws + WS_H); P.nrows = ML; norm_phase(P); }
    SEAM(11);
    if (IN(12)) REP(12) ffn_gu(lds, ws, 2, ML / 256);
    SEAM(12);
    if (IN(13)) REP(13) gemm_y(lds, ws, (const char*)(ws + WS_ACT), (const char*)(ws + WS_WDN + 2 * SZ_WDN), DFF, ML / 256);
    SEAM(13);
    if (IN(14)) REP(14) { NormP P{}; P.xin_lat = xres; P.xin_ctx = ctx_in; P.xout = xres; P.xin_bf = 1; P.xout_bf = 1; P.Y = (const bf16_t*)(ws + WS_Y); P.part = (const float*)(ws + WS_PART);
        P.do_post = 1; P.mod_post = mod1; P.kpost = 0; P.gpost = ng1 + 1 * D; P.coef = 0.5f;
        P.do_pre = 1; P.mod_pre = mod1; P.kpre = 1; P.gpre = ng1 + 2 * D; P.H = (bf16_t*)(ws + WS_H); P.nrows = ML; norm_phase(P); }
    SEAM(14);
    if (IN(15)) REP(15) {
        pg8::Sched S = sched_init(lds, D, nullptr); const char* Hb = (const char*)(ws + WS_H); const char* W = (const char*)(ws + WS_WODIN);
        pg8::seg_set(S, 0, Hb, W, (bf16_t*)(ws + WS_CX), 128, 8, D, pg8::M_MUL);
        pg8::seg_set(S, 1, Hb, W + (size_t)2048 * D * 2, (bf16_t*)(ws + WS_BG), 128, 4, D, pg8::M_PLAIN);
        __syncthreads();
        pg8::gemm_phase(lds, S);
    }
    SEAM(15);
    if (IN(16)) REP(16) conv3_phase((const bf16_t*)(ws + WS_CX), (const bf16_t*)(ws + WS_BG), args.in[19], yab);
    SEAM(16);
    if (IN(17)) REP(17) gemm_y(lds, ws, (const char*)yab, (const char*)(ws + WS_WODOUT), D, ML / 256);
    SEAM(17);
    if (IN(18)) REP(18) { NormP P{}; P.xin_lat = xres; P.xin_ctx = ctx_in; P.xout = xres; P.xin_bf = 1; P.xout_bf = 1; P.Y = (const bf16_t*)(ws + WS_Y); P.part = (const float*)(ws + WS_PART);
        P.do_post = 1; P.mod_post = mod1; P.kpost = 1; P.gpost = ng1 + 3 * D; P.coef = 1.0f;
        P.do_pre = 1; P.mod_pre = mod1; P.kpre = 2; P.gpre = ng1 + 4 * D; P.H = (bf16_t*)(ws + WS_H); P.nrows = ML; norm_phase(P); }
    SEAM(18);
    if (IN(19)) REP(19) ffn_gu(lds, ws, 3, ML / 256);
    SEAM(19);
    if (IN(20)) REP(20) gemm_y(lds, ws, (const char*)(ws + WS_ACT), (const char*)(ws + WS_WDN + 3 * SZ_WDN), DFF, ML / 256);
    SEAM(20);
    if (IN(21)) REP(21) { NormP P{}; P.xin_lat = xres; P.xin_ctx = ctx_in; P.xout = args.out; P.xin_bf = 1; P.xout_bf = 0; P.Y = (const bf16_t*)(ws + WS_Y); P.part = (const float*)(ws + WS_PART);
        P.do_post = 1; P.mod_post = mod1; P.kpost = 2; P.gpost = ng1 + 5 * D; P.coef = 0.5f; P.do_pre = 0; P.nrows = ML; norm_phase(P); }
    if (hi > NPH + 1) grid.sync();
#undef IN
#undef SEAM
}

extern "C" void kernel_launch(void* const* d_in, const int* in_sizes, int n_in, void* d_out, int out_size, void* d_ws, size_t ws_size, hipStream_t stream) {
    static int grid = 0;
    if (grid == 0) {
        if (n_in != 21 || out_size != ML * D || ws_size < WS_END) { fprintf(stderr, "kernel_launch: unexpected shapes (n_in %d out %d ws %zu need %zu)\n", n_in, out_size, ws_size, (size_t)WS_END); grid = -1; return; }
        int dev = 0, cus = 0, per_cu = 0;
        (void)hipGetDevice(&dev); (void)hipDeviceGetAttribute(&cus, hipDeviceAttributeMultiprocessorCount, dev);
        if (hipFuncSetAttribute((const void*)fwd_kernel, hipFuncAttributeMaxDynamicSharedMemorySize, LDS_BYTES) != hipSuccess) { fprintf(stderr, "kernel_launch: hipFuncSetAttribute failed\n"); grid = -1; return; }
        if (hipOccupancyMaxActiveBlocksPerMultiprocessor(&per_cu, (const void*)fwd_kernel, NTHREADS, LDS_BYTES) != hipSuccess || per_cu < 1) { fprintf(stderr, "kernel_launch: occupancy query says %d\n", per_cu); per_cu = 1; }
        (void)hipGetLastError();
        grid = cus * 1;
    }
    if (grid < 0) return;
    Args a{};
    for (int i = 0; i < 21; ++i) a.in[i] = (const float*)d_in[i];
    a.out = (float*)d_out; a.ws = (unsigned char*)d_ws;
#if ONE_LAUNCH
    (void)hipMemsetAsync((unsigned char*)d_ws + WS_CTL, 0, CTL_BYTES, stream);
    a.ph_lo = 0; a.ph_hi = NPH;
    void* kargs[] = {&a};
    hipError_t e = hipLaunchCooperativeKernel((const void*)fwd_kernel, dim3(grid), dim3(NTHREADS), kargs, LDS_BYTES, stream);
    if (e != hipSuccess) fprintf(stderr, "cooperative launch failed: %s (grid %d)\n", hipGetErrorString(e), grid);
#else
    for (int p = 0; p < NPH; ++p) { a.ph_lo = p; a.ph_hi = p + 1; hipLaunchKernelGGL(fwd_kernel, dim3(grid), dim3(NTHREADS), LDS_BYTES, stream, a); }
#endif
}
```
